# Optimizing an MI355X kernel written in HIP

```python
import math
import jax
import jax.numpy as jnp
from jax import lax
import numpy as np

D_MODEL = 1024
BATCH = 32
SEQ = 256
DEPTH = 2
DEC_BATCH = 4
DEC_SEQ = 1024
PAST_LEN = 256

GRID_W = 64
N_MIXERS = 2
N_ATTN_LAYERS = (DEPTH + 1) // 2
N_REC_LAYERS = DEPTH // 2
N_HEADS = 16
N_KV_HEADS = 4
HEAD_DIM = D_MODEL // N_HEADS
AXIS_DIM = HEAD_DIM // 2
ATTN_WIDTH = N_HEADS * HEAD_DIM
KV_WIDTH = N_KV_HEADS * HEAD_DIM
Q_BLOCK = 128
ROPE_THETA = 10000.0
REC_EXPAND = 128
N_REC_HEADS = D_MODEL // REC_EXPAND
REC_DK = REC_EXPAND
REC_DV = D_MODEL // N_REC_HEADS
REC_KEY_WIDTH = N_REC_HEADS * REC_DK
REC_VAL_WIDTH = N_REC_HEADS * REC_DV
CHUNK = 16
NORM_EPS = 1e-6
LN_EPS = 1e-5
DEEPNORM_ALPHA = (2.0 * DEPTH) ** 0.25
DEEPNORM_BETA = (8.0 * DEPTH) ** -0.25

kernel_name = "hybrid_gqa_hgrn2_diffusion_step"


def _rms_norm(x, g):
    xf = x.astype(jnp.float32)
    y = xf * lax.rsqrt(jnp.mean(xf * xf, axis=-1, keepdims=True) + NORM_EPS)
    return (y * g.astype(jnp.float32)).astype(x.dtype)


def _layer_norm(x, g, b):
    xf = x.astype(jnp.float32)
    mu = jnp.mean(xf, axis=-1, keepdims=True)
    var = jnp.mean(jnp.square(xf - mu), axis=-1, keepdims=True)
    y = (xf - mu) * lax.rsqrt(var + LN_EPS) * g.astype(jnp.float32) + b.astype(jnp.float32)
    return y.astype(x.dtype)


def _adaln(cond, w, b):
    mod = jax.nn.silu(cond.astype(jnp.float32)) @ w.astype(jnp.float32) + b.astype(jnp.float32)
    mod = mod.astype(cond.dtype)
    return jnp.split(mod, 3, axis=-1)


def _axial_rope(n_tokens):
    n_rows = n_tokens // GRID_W
    rows = jnp.repeat(jnp.arange(n_rows, dtype=jnp.float32), GRID_W)
    cols = jnp.tile(jnp.arange(GRID_W, dtype=jnp.float32), n_rows)
    inv_freq = 1.0 / (ROPE_THETA ** (jnp.arange(0, AXIS_DIM, 2, dtype=jnp.float32) / AXIS_DIM))
    ang_r = rows[:, None] * inv_freq[None, :]
    ang_c = cols[:, None] * inv_freq[None, :]
    ang = jnp.concatenate([ang_r, ang_r, ang_c, ang_c], axis=-1)
    return jnp.cos(ang)[:, None, :], jnp.sin(ang)[:, None, :]


def _apply_rope(x, cos, sin):
    xf = x.astype(jnp.float32)

    def rot_half(u):
        u1, u2 = jnp.split(u, 2, axis=-1)
        return jnp.concatenate([-u2, u1], axis=-1)

    xr, xc = jnp.split(xf, 2, axis=-1)
    rotated = jnp.concatenate([rot_half(xr), rot_half(xc)], axis=-1)
    return (xf * cos + rotated * sin).astype(x.dtype)


def _block_attention(q, k, v):
    B, Lq, H, d = q.shape
    G = H // N_KV_HEADS
    nb = Lq // Q_BLOCK
    qb = q.reshape(B, nb, Q_BLOCK, N_KV_HEADS, G, d).transpose(1, 0, 2, 3, 4, 5)
    kf = k.astype(jnp.float32)
    vf = v.astype(jnp.float32)
    scale = 1.0 / math.sqrt(d)

    def one_block(q_blk):
        s = jnp.einsum('bqkgd,bskd->bkgqs', q_blk.astype(jnp.float32), kf) * scale
        p = jax.nn.softmax(s, axis=-1)
        return jnp.einsum('bkgqs,bskd->bqkgd', p, vf).astype(q.dtype)

    out = lax.map(one_block, qb)
    return out.transpose(1, 0, 2, 3, 4, 5).reshape(B, Lq, H, d)


def _attn_project(h, w_in, q_gain, k_gain):
    B, L, _ = h.shape
    proj = h @ w_in
    q, k, v, g = jnp.split(proj, [ATTN_WIDTH, ATTN_WIDTH + KV_WIDTH, ATTN_WIDTH + 2 * KV_WIDTH], axis=-1)
    q = _rms_norm(q.reshape(B, L, N_HEADS, HEAD_DIM), q_gain)
    k = _rms_norm(k.reshape(B, L, N_KV_HEADS, HEAD_DIM), k_gain)
    v = v.reshape(B, L, N_KV_HEADS, HEAD_DIM)
    return q, k, v, g


def _attn_out(o, g, w_out):
    B, L = o.shape[0], o.shape[1]
    gated = o.reshape(B, L, ATTN_WIDTH).astype(jnp.float32) * jax.nn.silu(g.astype(jnp.float32))
    return gated.astype(o.dtype) @ w_out


def _attn_context(h, w_in, q_gain, k_gain, w_out):
    q, k, v, g = _attn_project(h, w_in, q_gain, k_gain)
    o = _block_attention(q, k, v)
    return _attn_out(o, g, w_out), k, v


def _attn_latent(h, ctx_k, ctx_v, w_in, q_gain, k_gain, w_out):
    q, k, v, g = _attn_project(h, w_in, q_gain, k_gain)
    cos, sin = _axial_rope(h.shape[1])
    q = _apply_rope(q, cos, sin)
    k = _apply_rope(k, cos, sin)
    keys = jnp.concatenate([ctx_k.astype(k.dtype), k], axis=1)
    vals = jnp.concatenate([ctx_v.astype(v.dtype), v], axis=1)
    o = _block_attention(q, keys, vals)
    return _attn_out(o, g, w_out)


def _gla_chunked(q, k, v, log_f, s0):
    B, H, L, dk = q.shape
    dv = v.shape[-1]
    n = L // CHUNK

    def chunks(u):
        return jnp.moveaxis(u.reshape(B, H, n, CHUNK, u.shape[-1]), 2, 0)

    b = jnp.cumsum(chunks(log_f), axis=3)
    mask = jnp.tril(jnp.ones((CHUNK, CHUNK), dtype=bool))[:, :, None]

    def step(S, xs):
        q_i, k_i, v_i, b_i = xs
        diff = b_i[:, :, :, None, :] - b_i[:, :, None, :, :]
        decay = jnp.where(mask, jnp.exp(jnp.minimum(diff, 0.0)), 0.0)
        scores = jnp.einsum('bhtk,bhsk,bhtsk->bhts', q_i, k_i, decay)
        b_last = b_i[:, :, -1, :]
        o_i = (jnp.einsum('bhts,bhsv->bhtv', scores, v_i)
               + jnp.einsum('bhtk,bhkv->bhtv', q_i * jnp.exp(b_i), S))
        S = (jnp.exp(b_last)[..., None] * S
             + jnp.einsum('bhsk,bhsv->bhkv', k_i * jnp.exp(b_last[:, :, None, :] - b_i), v_i))
        return S, o_i

    s_fin, o = lax.scan(step, s0.astype(jnp.float32), (chunks(q), chunks(k), chunks(v), b))
    o = jnp.moveaxis(o, 0, 2).reshape(B, H, L, dv)
    return o, s_fin


def _rec_mix(h, s0_fw, s0_bw, w_in, lb, norm_gain, w_out):
    B, L, _ = h.shape
    proj = h @ w_in
    q, f_fw, f_bw, i_in, g = jnp.split(
        proj, [REC_KEY_WIDTH, 2 * REC_KEY_WIDTH, 3 * REC_KEY_WIDTH, 3 * REC_KEY_WIDTH + REC_VAL_WIDTH], axis=-1)

    def heads(u, dh):
        return u.astype(jnp.float32).reshape(B, L, N_REC_HEADS, dh).transpose(0, 2, 1, 3)

    qh = jax.nn.silu(heads(q, REC_DK))
    vh = heads(i_in, REC_DV)
    lbf = lb.astype(jnp.float32)

    def gates(f_raw, lb_d):
        z = heads(f_raw, REC_DK)
        lb_h = lb_d.reshape(N_REC_HEADS, 1, REC_DK)
        forget = lb_h + (1.0 - lb_h) * jax.nn.sigmoid(z)
        inp = (1.0 - lb_h) * jax.nn.sigmoid(-z)
        return jnp.log(forget), inp

    lf_fw, k_fw = gates(f_fw, lbf[0])
    lf_bw, k_bw = gates(f_bw, lbf[1])
    o_fw, s_fw = _gla_chunked(qh, k_fw, vh, lf_fw, s0_fw)

    def flip(u):
        return jnp.flip(u, axis=2)

    o_bw, s_bw = _gla_chunked(flip(qh), flip(k_bw), flip(vh), flip(lf_bw), s0_bw)
    o = (o_fw + flip(o_bw)).transpose(0, 2, 1, 3)
    o = _rms_norm(o, norm_gain).reshape(B, L, REC_VAL_WIDTH)
    gated = (o * jax.nn.silu(g.astype(jnp.float32))).astype(h.dtype)
    return gated @ w_out, s_fw, s_bw


def setup_inputs(seed: int = 0) -> dict:
    key = jax.random.key(seed)
    ks = jax.random.split(key, 20)
    f32 = jnp.float32
    attn_in_w = 2 * ATTN_WIDTH + 2 * KV_WIDTH
    rec_in_w = 3 * REC_KEY_WIDTH + 2 * REC_VAL_WIDTH
    return {
        'x_prompt': jax.random.normal(ks[0], (BATCH, SEQ, D_MODEL), f32),
        'x_sample': jax.random.normal(ks[1], (DEC_BATCH, DEC_SEQ, D_MODEL), f32),
        'cache_k': jax.random.normal(ks[2], (DEC_BATCH, N_ATTN_LAYERS, PAST_LEN, N_KV_HEADS, HEAD_DIM), f32),
        'cache_v': jax.random.normal(ks[3], (DEC_BATCH, N_ATTN_LAYERS, PAST_LEN, N_KV_HEADS, HEAD_DIM), f32),
        'state_rec': 0.5 * jax.random.normal(ks[4], (DEC_BATCH, N_REC_LAYERS, 2, N_REC_HEADS, REC_DK, REC_DV), f32),
        'c': jax.random.normal(ks[5], (DEC_BATCH, D_MODEL), f32),
        'c_ctx': jax.random.normal(ks[6], (D_MODEL,), f32),
        'ada_w': 0.3 * D_MODEL ** -0.5 * jax.random.normal(ks[7], (DEPTH, D_MODEL, 3 * D_MODEL), f32),
        'ada_b': 0.02 * jax.random.normal(ks[8], (DEPTH, 3 * D_MODEL), f32),
        'attn_w_in': D_MODEL ** -0.5 * jax.random.normal(ks[9], (N_ATTN_LAYERS, D_MODEL, attn_in_w), f32),
        'attn_q_gain': 1.0 + 0.05 * jax.random.normal(ks[10], (N_ATTN_LAYERS, HEAD_DIM), f32),
        'attn_k_gain': 1.0 + 0.05 * jax.random.normal(ks[11], (N_ATTN_LAYERS, HEAD_DIM), f32),
        'attn_w_out': DEEPNORM_BETA * ATTN_WIDTH ** -0.5 * jax.random.normal(ks[12], (N_ATTN_LAYERS, ATTN_WIDTH, D_MODEL), f32),
        'rec_w_in': D_MODEL ** -0.5 * jax.random.normal(ks[13], (N_REC_LAYERS, D_MODEL, rec_in_w), f32),
        'rec_lower_bounds': 0.1 * jax.random.normal(ks[14], (DEPTH, 2, REC_KEY_WIDTH), f32),
        'rec_norm_gain': 1.0 + 0.05 * jax.random.normal(ks[15], (N_REC_LAYERS, REC_DV), f32),
        'rec_w_out': DEEPNORM_BETA * REC_VAL_WIDTH ** -0.5 * jax.random.normal(ks[16], (N_REC_LAYERS, REC_VAL_WIDTH, D_MODEL), f32),
        'ln_gain': 1.0 + 0.05 * jax.random.normal(ks[17], (DEPTH, D_MODEL), f32),
        'ln_bias': 0.02 * jax.random.normal(ks[18], (DEPTH, D_MODEL), f32),
    }


def reference(x_prompt, x_sample, cache_k, cache_v, state_rec, c, c_ctx,
              ada_w, ada_b, attn_w_in, attn_q_gain, attn_k_gain, attn_w_out,
              rec_w_in, rec_lower_bounds, rec_norm_gain, rec_w_out, ln_gain, ln_bias):
    lb_soft = jax.nn.softmax(rec_lower_bounds.astype(jnp.float32), axis=0)
    lb_all = jnp.cumsum(lb_soft, axis=0) - lb_soft[0]

    xp = x_prompt
    xs = x_sample
    new_k, new_v, new_s = [], [], []
    for i in range(DEPTH):
        j = i // N_MIXERS
        sh_p, sc_p, g_p = _adaln(c_ctx, ada_w[i], ada_b[i])
        sh_s, sc_s, g_s = _adaln(c, ada_w[i], ada_b[i])
        sh_s, sc_s, g_s = sh_s[:, None, :], sc_s[:, None, :], g_s[:, None, :]
        hp = xp * (1.0 + sc_p) + sh_p
        hs = xs * (1.0 + sc_s) + sh_s
        if i % N_MIXERS == 0:
            out_p, kp, vp = _attn_context(hp, attn_w_in[j], attn_q_gain[j], attn_k_gain[j], attn_w_out[j])
            new_k.append(kp.astype(x_prompt.dtype))
            new_v.append(vp.astype(x_prompt.dtype))
            out_s = _attn_latent(hs, cache_k[:, j], cache_v[:, j], attn_w_in[j], attn_q_gain[j],
                                 attn_k_gain[j], attn_w_out[j])
        else:
            zeros = jnp.zeros((xp.shape[0], N_REC_HEADS, REC_DK, REC_DV), jnp.float32)
            out_p, sp_fw, sp_bw = _rec_mix(hp, zeros, zeros, rec_w_in[j], lb_all[i],
                                           rec_norm_gain[j], rec_w_out[j])
            new_s.append(jnp.stack([sp_fw, sp_bw], axis=1).astype(x_prompt.dtype))
            out_s, _, _ = _rec_mix(hs, state_rec[:, j, 0], state_rec[:, j, 1], rec_w_in[j], lb_all[i],
                                   rec_norm_gain[j], rec_w_out[j])
        xp = _layer_norm(DEEPNORM_ALPHA * xp + g_p * out_p, ln_gain[i], ln_bias[i])
        xs = _layer_norm(DEEPNORM_ALPHA * xs + g_s * out_s, ln_gain[i], ln_bias[i])

    new_cache_k = jnp.stack(new_k, axis=1)
    new_cache_v = jnp.stack(new_v, axis=1)
    new_state_rec = jnp.stack(new_s, axis=1)
    return (xp, xs, new_cache_k, new_cache_v, new_state_rec)
```

```cpp
#include <hip/hip_runtime.h>
#include <hip/hip_bf16.h>
#include <cstdio>
#include <cstdint>
#include <cmath>
#ifndef MK_N_LAUNCHES
#define MK_N_LAUNCHES 1
#endif
namespace pg8 {
#define PG8_LAS __attribute__((address_space(3)))
typedef unsigned short bf16_t;
typedef short bf16x8 __attribute__((ext_vector_type(8)));
typedef float f32x4 __attribute__((ext_vector_type(4)));
typedef unsigned u32x4 __attribute__((ext_vector_type(4)));
constexpr int BM = 256, BK = 64, HALF = 128, HTB = HALF * BK * 2  , STAGE_BYTES = 8 * HTB, NXCD = 8, WGM = 8;

__host__ __device__ __forceinline__ int lds_byte(int r, int c) { const int st = (r >> 4) * 2 + (c >> 5), rr = r & 15, cc = c & 31, ob = rr * 64 + cc * 2; return st * 1024 + (ob ^ (((ob >> 9) & 1) << 5)); }
__host__ __device__ __forceinline__ void stage_rc(int b, int& R, int& C) { const int st = b / 1024, sb = b % 1024, swz = sb ^ (((sb >> 9) & 1) << 5); R = (st >> 1) * 16 + swz / 64; C = (st & 1) * 32 + (swz % 64) / 2; }
__host__ __device__ __forceinline__ int perm32(int rho) { const int n = rho >> 4, i = rho & 15; return 8 * (i >> 2) + 4 * n + (i & 3); }

struct Unit { int pm, pn; };
struct Gemm { const bf16_t* A; const bf16_t* Bt; int M, N, K; };

struct StaticOrder {
    int nM, nN, nwg, G, c;
    __host__ __device__ void init(int M, int N, int G_, int c_) { nM = M / BM; nN = N / BM; nwg = nM * nN; G = G_; c = c_; }
    __host__ __device__ bool next(int i, Unit& u) const {
        const long L = (long)i * G + c; if (L >= nwg) return false;
        int wgid = (int)L; { const int q = nwg / NXCD, r = nwg % NXCD, xcd = wgid % NXCD, off = wgid / NXCD; wgid = (xcd < r ? xcd * (q + 1) : r * (q + 1) + (xcd - r) * q) + off; }
        const int nig = WGM * nN, gid = wgid / nig, fm = gid * WGM, gsz = (nM - fm) < WGM ? (nM - fm) : WGM;
        u.pm = fm + ((wgid % nig) % gsz); u.pn = (wgid % nig) / gsz; return true;
    }
    __device__ __forceinline__ void a_ready(const Unit&) const {}
    __device__ __forceinline__ void done(const Unit&) const {}
};
__device__ __forceinline__ unsigned cvt_pk_bf16(float lo, float hi) { unsigned r; asm volatile("v_cvt_pk_bf16_f32 %0, %1, %2" : "=v"(r) : "v"(lo), "v"(hi)); return r; }
typedef unsigned u32x2 __attribute__((ext_vector_type(2)));
typedef _Float16 f16x8 __attribute__((ext_vector_type(8)));
__device__ __forceinline__ float siluf(float x) { return x / (1.f + __expf(-x)); }
__device__ __forceinline__ u32x2 pk4(const f32x4 x) { u32x2 w; w.x = cvt_pk_bf16(x[0], x[1]); w.y = cvt_pk_bf16(x[2], x[3]); return w; }
__device__ __forceinline__ u32x4 pk8(const f32x4 a, const f32x4 b) { u32x4 w; w.x = cvt_pk_bf16(a[0], a[1]); w.y = cvt_pk_bf16(a[2], a[3]); w.z = cvt_pk_bf16(b[0], b[1]); w.w = cvt_pk_bf16(b[2], b[3]); return w; }
constexpr float ATT_C2 = 0.125f * 1.4426950408889634f;
constexpr int MROWS = 12288, MPROMPT = 8192;
struct EpiAttnIn {
    static constexpr bool PERM = false, AFTER_DRAIN = false;
    bf16_t *Q, *Kall, *Vall, *G; float *outK, *outV; const float *qgain, *kgain, *rope;
    __device__ __forceinline__ void operator()(const f32x4 (&acc)[2][2][4][2], const Unit& u, int wr, int wc, int fr, int fq) const {
        const int pn = u.pn; const bool samp = u.pm >= 32;
        const int rbase = u.pm * BM + wr * 64 + fr;
        if (pn <= 4) {
            const bool isq = pn < 4; const float* gain = isq ? qgain : kgain;
            f32x4 gv[2][2];
#pragma unroll
            for (int bj = 0; bj < 2; ++bj)
#pragma unroll
                for (int n = 0; n < 2; ++n) gv[bj][n] = *(const f32x4*)(gain + 32 * bj + 16 * n + 4 * fq);
#pragma unroll
            for (int ai = 0; ai < 2; ++ai)
#pragma unroll
                for (int m = 0; m < 4; ++m) {
                    const int r = rbase + ai * HALF + m * 16;
                    f32x4 v[2][2]; float ss = 0.f;
#pragma unroll
                    for (int bj = 0; bj < 2; ++bj)
#pragma unroll
                        for (int n = 0; n < 2; ++n) { const f32x4 x = acc[ai][bj][m][n]; v[bj][n] = x; ss += (x[0] * x[0] + x[1] * x[1]) + (x[2] * x[2] + x[3] * x[3]); }
                    ss += __shfl_xor(ss, 16); ss += __shfl_xor(ss, 32);
                    const float rinv = rsqrtf(ss * (1.0f / 64.0f) + 1e-6f);
#pragma unroll
                    for (int bj = 0; bj < 2; ++bj)
#pragma unroll
                        for (int n = 0; n < 2; ++n) v[bj][n] = v[bj][n] * rinv * gv[bj][n];
                    int krow = r;
                    if (samp) {
                        const int rs = r - MPROMPT, t = rs & 1023, b = rs >> 10; krow = MPROMPT + b * 1280 + 256 + t;
#pragma unroll
                        for (int bj = 0; bj < 2; ++bj) { const int pos = bj ? (t & 63) : (t >> 6);
                            const f32x4 cs = *(const f32x4*)(rope + pos * 32 + 4 * fq), sn = *(const f32x4*)(rope + pos * 32 + 16 + 4 * fq);
                            const f32x4 a = v[bj][0], b2 = v[bj][1]; v[bj][0] = a * cs - b2 * sn; v[bj][1] = b2 * cs + a * sn; }
                    }
                    if (isq) { bf16_t* dst = Q + (size_t)r * 1024 + pn * 256 + wc * 64 + 4 * fq;
#pragma unroll
                        for (int bj = 0; bj < 2; ++bj)
#pragma unroll
                            for (int n = 0; n < 2; ++n) *(u32x2*)(dst + 32 * bj + 16 * n) = pk4(v[bj][n] * ATT_C2);
                    } else {
                        if (!samp) { float* dk = outK + (size_t)r * 256 + wc * 64 + 4 * fq;
#pragma unroll
                            for (int bj = 0; bj < 2; ++bj)
#pragma unroll
                                for (int n = 0; n < 2; ++n) *(f32x4*)(dk + 32 * bj + 16 * n) = v[bj][n]; }
                        bf16_t* dst = Kall + (size_t)krow * 256 + wc * 64 + 4 * fq;
#pragma unroll
                        for (int bj = 0; bj < 2; ++bj)
#pragma unroll
                            for (int n = 0; n < 2; ++n) *(u32x2*)(dst + 32 * bj + 16 * n) = pk4(v[bj][n]);
                    }
                }
        } else if (pn == 5) {
#pragma unroll
            for (int ai = 0; ai < 2; ++ai)
#pragma unroll
                for (int m = 0; m < 4; ++m) {
                    const int r = rbase + ai * HALF + m * 16; int vrow = r;
                    if (samp) { const int rs = r - MPROMPT; vrow = MPROMPT + (rs >> 10) * 1280 + 256 + (rs & 1023); }
#pragma unroll
                    for (int bj = 0; bj < 2; ++bj) { const int L = 128 * bj + 32 * wc + 8 * fq; const f32x4 x0 = acc[ai][bj][m][0], x1 = acc[ai][bj][m][1];
                        if (!samp) { *(f32x4*)(outV + (size_t)r * 256 + L) = x0; *(f32x4*)(outV + (size_t)r * 256 + L + 4) = x1; }
                        *(u32x4*)(Vall + (size_t)vrow * 256 + L) = pk8(x0, x1); }
                }
        } else {
#pragma unroll
            for (int ai = 0; ai < 2; ++ai)
#pragma unroll
                for (int m = 0; m < 4; ++m) {
                    const int r = rbase + ai * HALF + m * 16;
#pragma unroll
                    for (int bj = 0; bj < 2; ++bj) { f32x4 x0 = acc[ai][bj][m][0], x1 = acc[ai][bj][m][1];
#pragma unroll
                        for (int e = 0; e < 4; ++e) { x0[e] = siluf(x0[e]); x1[e] = siluf(x1[e]); }
                        *(u32x4*)(G + (size_t)r * 1024 + (pn - 6) * 256 + 128 * bj + 32 * wc + 8 * fq) = pk8(x0, x1); }
                }
        }
    }
};
struct EpiRes {
    static constexpr bool PERM = false, AFTER_DRAIN = false;
    const float *xp, *xs; float* Y; const float* gate;
    __device__ __forceinline__ void operator()(const f32x4 (&acc)[2][2][4][2], const Unit& u, int wr, int wc, int fr, int fq) const {
        const int cond = u.pm < 32 ? 0 : 1 + ((u.pm - 32) >> 2);
        const int col0 = u.pn * BM + wc * 32 + 4 * fq, rbase = u.pm * BM + wr * 64 + fr;
        f32x4 g4[2][2];
#pragma unroll
        for (int bj = 0; bj < 2; ++bj)
#pragma unroll
            for (int n = 0; n < 2; ++n) g4[bj][n] = *(const f32x4*)(gate + cond * 3072 + col0 + bj * HALF + n * 16);
#pragma unroll
        for (int ai = 0; ai < 2; ++ai)
#pragma unroll
            for (int m = 0; m < 4; ++m) {
                const int r = rbase + ai * HALF + m * 16;
                const float* xr = (r < MPROMPT ? xp + (size_t)r * 1024 : xs + (size_t)(r - MPROMPT) * 1024) + col0;
                float* yr = Y + (size_t)r * 1024 + col0;
#pragma unroll
                for (int bj = 0; bj < 2; ++bj)
#pragma unroll
                    for (int n = 0; n < 2; ++n) { const f32x4 x = *(const f32x4*)(xr + bj * HALF + n * 16); *(f32x4*)(yr + bj * HALF + n * 16) = x * 1.41421356237f + g4[bj][n] * acc[ai][bj][m][n]; }
            }
    }
};
struct EpiRecIn {
    static constexpr bool PERM = false, AFTER_DRAIN = false;
    bf16_t *QR, *KR, *VR, *GR; _Float16* LF; const float* rlb;
    __device__ __forceinline__ void operator()(const f32x4 (&acc)[2][2][4][2], const Unit& u, int wr, int wc, int fr, int fq) const {
        const int type = u.pn >> 2, cb = (u.pn & 3) * 256 + 32 * wc + 8 * fq, rbase = u.pm * BM + wr * 64 + fr;
        if (type == 1 || type == 2) {
            const int d = type - 1; f32x4 oml[2][2];
#pragma unroll
            for (int bj = 0; bj < 2; ++bj)
#pragma unroll
                for (int n = 0; n < 2; ++n) { const f32x4 r0 = *(const f32x4*)(rlb + (0 * 2 + d) * 1024 + cb + 128 * bj + 4 * n), r1 = *(const f32x4*)(rlb + (1 * 2 + d) * 1024 + cb + 128 * bj + 4 * n);
#pragma unroll
                    for (int e = 0; e < 4; ++e) oml[bj][n][e] = 1.f - 1.f / (1.f + __expf(r0[e] - r1[e])); }
#pragma unroll
            for (int ai = 0; ai < 2; ++ai)
#pragma unroll
                for (int m = 0; m < 4; ++m) {
                    const size_t ro = ((size_t)d * MROWS + (rbase + ai * HALF + m * 16)) * 1024 + cb;
#pragma unroll
                    for (int bj = 0; bj < 2; ++bj) { f32x4 k0, k1; f16x8 lf;
#pragma unroll
                        for (int e = 0; e < 4; ++e) { k0[e] = oml[bj][0][e] / (1.f + __expf(acc[ai][bj][m][0][e])); k1[e] = oml[bj][1][e] / (1.f + __expf(acc[ai][bj][m][1][e]));
                            lf[e] = (_Float16)__logf(1.f - k0[e]); lf[4 + e] = (_Float16)__logf(1.f - k1[e]); }
                        *(f16x8*)(LF + ro + 128 * bj) = lf; *(u32x4*)(KR + ro + 128 * bj) = pk8(k0, k1); }
                }
        } else if (type == 0) { plain<true>(QR, acc, rbase, cb);
        } else if (type == 3) { plain<false>(VR, acc, rbase, cb);
        } else { plain<true>(GR, acc, rbase, cb); }
    }
    template <bool ACT> __device__ __forceinline__ void plain(bf16_t* dstb, const f32x4 (&acc)[2][2][4][2], int rbase, int cb) const {
#pragma unroll
        for (int ai = 0; ai < 2; ++ai)
#pragma unroll
            for (int m = 0; m < 4; ++m) {
                const size_t ro = (size_t)(rbase + ai * HALF + m * 16) * 1024 + cb;
#pragma unroll
                for (int bj = 0; bj < 2; ++bj) { f32x4 x0 = acc[ai][bj][m][0], x1 = acc[ai][bj][m][1];
                    if (ACT) {
#pragma unroll
                        for (int e = 0; e < 4; ++e) { x0[e] = siluf(x0[e]); x1[e] = siluf(x1[e]); } }
                    *(u32x4*)(dstb + ro + 128 * bj) = pk8(x0, x1); }
            }
    }
};
template <class Epi, class Sched, bool ALIGN_EPI = false, bool SP2 = false>
__device__ __forceinline__ void gemm_phase(PG8_LAS unsigned char* lds, const Gemm g, const Sched& S, const Epi& E) {
    const int tid = threadIdx.x, wid = __builtin_amdgcn_readfirstlane(tid >> 6), lane = tid & 63, wr = wid >> 2, wc = wid & 3, fr = lane & 15, fq = lane >> 4;
    const int K = g.K, nt = K / BK;
    unsigned voffA[2], voffB[2];
#pragma unroll
    for (int i = 0; i < 2; ++i) { int R, C; stage_rc(tid * 16 + i * 8192, R, C); const int Rb = Epi::PERM ? ((R & ~31) + perm32(R & 31)) : R;
        voffA[i] = (unsigned)(R * K + C) * 2u; voffB[i] = (unsigned)(Rb * K + C) * 2u; }
    const size_t kstep = (size_t)(BK * 2);
    const size_t hstep = (size_t)HALF * K * 2;
    const size_t tstep = 2 * hstep;
    const unsigned ldsw = (unsigned)wid * 1024u;
    const int aoff = lds_byte(wr * 64 + fr, fq * 8), boff = lds_byte(wc * 32 + fr, fq * 8);
#define PG8_SA(b, h) (((b) * 2 + (h)) * HTB)
#define PG8_SB(b, h) ((4 + (b) * 2 + (h)) * HTB)
#define PG8_STAGE(bufoff, gbase, voff) do { _Pragma("unroll") for (int _i = 0; _i < 2; ++_i) \
        __builtin_amdgcn_global_load_lds((const unsigned*)((const char*)(gbase) + (voff)[_i]), (PG8_LAS unsigned*)(lds + (bufoff) + ldsw + _i * 8192), 16, 0, 0); } while (0)
#define PG8_LDA(dst, b, h) do { _Pragma("unroll") for (int m = 0; m < 4; ++m) _Pragma("unroll") for (int k = 0; k < 2; ++k) dst[m][k] = *(const PG8_LAS bf16x8*)(lds + PG8_SA(b, h) + aoff + m * 2048 + k * 1024); } while (0)
#define PG8_LDB(dst, b, h) do { _Pragma("unroll") for (int n = 0; n < 2; ++n) _Pragma("unroll") for (int k = 0; k < 2; ++k) dst[n][k] = *(const PG8_LAS bf16x8*)(lds + PG8_SB(b, h) + boff + n * 2048 + k * 1024); } while (0)
#define PG8_MMA(ai, bj, At, Bt) do { __builtin_amdgcn_s_setprio(1); _Pragma("unroll") for (int m = 0; m < 4; ++m) _Pragma("unroll") for (int n = 0; n < 2; ++n) _Pragma("unroll") for (int k = 0; k < 2; ++k) \
        acc[ai][bj][m][n] = __builtin_amdgcn_mfma_f32_16x16x32_bf16(Bt[n][k], At[m][k], acc[ai][bj][m][n], 0, 0, 0); __builtin_amdgcn_s_setprio(0); } while (0)
#define PG8_WAIT_V(n) asm volatile("s_waitcnt vmcnt(" #n ")" ::: "memory")
#define PG8_WAIT_L(n) asm volatile("s_waitcnt lgkmcnt(" #n ")" ::: "memory")
#define PG8_BAR __builtin_amdgcn_s_barrier()
#define PG8_SCHED __builtin_amdgcn_sched_barrier(0)
    Unit cur, nxt; int ui = 0;
    if (!S.next(0, cur)) return;
    f32x4 acc[2][2][4][2];
#pragma unroll
    for (int a = 0; a < 2; ++a)
#pragma unroll
        for (int b = 0; b < 2; ++b)
#pragma unroll
            for (int m = 0; m < 4; ++m)
#pragma unroll
                for (int n = 0; n < 2; ++n) acc[a][b][m][n] = (f32x4){0.f, 0.f, 0.f, 0.f};
    bf16x8 At[4][2], B0[2][2], B1[2][2];
    const char* cA = (const char*)g.A + (size_t)cur.pm * tstep; const char* cB = (const char*)g.Bt + (size_t)cur.pn * tstep;
    S.a_ready(cur);
    if constexpr (SP2) {
        PG8_STAGE(PG8_SB(0, 0), cB, voffB); PG8_STAGE(PG8_SB(0, 1), cB + hstep, voffB); PG8_STAGE(PG8_SA(0, 0), cA, voffA); PG8_STAGE(PG8_SA(0, 1), cA + hstep, voffA);
        if (wr == 1) PG8_BAR;
        PG8_WAIT_V(2); PG8_BAR;
        PG8_STAGE(PG8_SB(1, 0), cB + kstep, voffB); PG8_STAGE(PG8_SA(1, 0), cA + kstep, voffA); PG8_STAGE(PG8_SB(1, 1), cB + hstep + kstep, voffB);
        PG8_WAIT_V(6); PG8_BAR;
    } else {
        PG8_STAGE(PG8_SB(0, 0), cB, voffB); PG8_STAGE(PG8_SA(0, 0), cA, voffA); PG8_STAGE(PG8_SB(0, 1), cB + hstep, voffB); PG8_STAGE(PG8_SA(0, 1), cA + hstep, voffA);
        if (wr == 1) PG8_BAR;
        PG8_WAIT_V(4); PG8_BAR;
        PG8_STAGE(PG8_SB(1, 0), cB + kstep, voffB); PG8_STAGE(PG8_SA(1, 0), cA + kstep, voffA); PG8_STAGE(PG8_SB(1, 1), cB + hstep + kstep, voffB);
        PG8_WAIT_V(6); PG8_BAR;
    }
    for (;;) {
        const bool has_next = S.next(ui + 1, nxt);
        const char* nA = has_next ? (const char*)g.A + (size_t)nxt.pm * tstep : cA; const char* nB = has_next ? (const char*)g.Bt + (size_t)nxt.pn * tstep : cB;
        for (int t = 0; t < nt; t += 2) {
            const bool last = (t == nt - 2);
            const char* a1 = cA + (size_t)(t + 1) * kstep;
            const char* a2 = last ? nA : cA + (size_t)(t + 2) * kstep; const char* b2 = last ? nB : cB + (size_t)(t + 2) * kstep;
            const char* a3 = a2 + kstep; const char* b3 = b2 + kstep;
            if (last && has_next) S.a_ready(nxt);
            if constexpr (SP2) {
            PG8_LDB(B0, 0, 0); PG8_LDB(B1, 0, 1); PG8_SCHED; PG8_LDA(At, 0, 0); PG8_STAGE(PG8_SA(1, 1), a1 + hstep, voffA);
            PG8_WAIT_V(8); PG8_WAIT_L(0); PG8_BAR; PG8_MMA(0, 0, At, B0); PG8_MMA(0, 1, At, B1); PG8_BAR; PG8_SCHED;
            PG8_LDA(At, 0, 1); PG8_STAGE(PG8_SB(0, 0), b2, voffB); PG8_STAGE(PG8_SB(0, 1), b2 + hstep, voffB); PG8_STAGE(PG8_SA(0, 0), a2, voffA);
            PG8_WAIT_V(8); PG8_WAIT_L(0); PG8_BAR; PG8_MMA(1, 0, At, B0); PG8_MMA(1, 1, At, B1); PG8_BAR; PG8_SCHED;
            PG8_LDB(B0, 1, 0); PG8_LDB(B1, 1, 1); PG8_SCHED; PG8_LDA(At, 1, 0); PG8_STAGE(PG8_SA(0, 1), a2 + hstep, voffA);
            PG8_WAIT_V(8); PG8_WAIT_L(0); PG8_BAR; PG8_MMA(0, 0, At, B0); PG8_MMA(0, 1, At, B1); PG8_BAR; PG8_SCHED;
            PG8_LDA(At, 1, 1); PG8_STAGE(PG8_SB(1, 0), b3, voffB); PG8_STAGE(PG8_SB(1, 1), b3 + hstep, voffB); PG8_STAGE(PG8_SA(1, 0), a3, voffA);
            PG8_WAIT_V(8); PG8_WAIT_L(0); PG8_BAR; PG8_MMA(1, 0, At, B0); PG8_MMA(1, 1, At, B1); PG8_BAR; PG8_SCHED;
            } else {
            PG8_LDB(B0, 0, 0); PG8_SCHED; PG8_LDA(At, 0, 0); PG8_STAGE(PG8_SA(1, 1), a1 + hstep, voffA);
            PG8_WAIT_L(8); PG8_BAR; PG8_WAIT_L(0); PG8_MMA(0, 0, At, B0); PG8_BAR; PG8_SCHED;
            PG8_LDB(B1, 0, 1); PG8_STAGE(PG8_SB(0, 0), b2, voffB);
            PG8_BAR; PG8_WAIT_L(0); PG8_MMA(0, 1, At, B1); PG8_BAR;
            PG8_LDA(At, 0, 1); PG8_STAGE(PG8_SA(0, 0), a2, voffA);
            PG8_BAR; PG8_WAIT_L(0); PG8_MMA(1, 0, At, B0); PG8_BAR; PG8_SCHED;
            PG8_STAGE(PG8_SB(0, 1), b2 + hstep, voffB);
            PG8_WAIT_V(6); PG8_BAR; PG8_MMA(1, 1, At, B1); PG8_BAR;
            PG8_LDB(B0, 1, 0); PG8_SCHED; PG8_LDA(At, 1, 0); PG8_STAGE(PG8_SA(0, 1), a2 + hstep, voffA);
            PG8_WAIT_L(8); PG8_BAR; PG8_WAIT_L(0); PG8_MMA(0, 0, At, B0); PG8_BAR; PG8_SCHED;
            PG8_LDB(B1, 1, 1); PG8_STAGE(PG8_SB(1, 0), b3, voffB);
            PG8_BAR; PG8_WAIT_L(0); PG8_MMA(0, 1, At, B1); PG8_BAR;
            PG8_LDA(At, 1, 1); PG8_STAGE(PG8_SA(1, 0), a3, voffA);
            PG8_BAR; PG8_WAIT_L(0); PG8_MMA(1, 0, At, B0); PG8_BAR; PG8_SCHED;
            PG8_STAGE(PG8_SB(1, 1), b3 + hstep, voffB);
            PG8_WAIT_V(6); PG8_BAR; PG8_MMA(1, 1, At, B1); PG8_BAR;
            }
        }
        if constexpr (ALIGN_EPI) { if (wr == 0) PG8_BAR; }
        if constexpr (!Epi::AFTER_DRAIN) { E(acc, cur, wr, wc, fr, fq); S.done(cur); }
        if (!has_next) break;
#pragma unroll
        for (int a = 0; a < 2; ++a)
#pragma unroll
            for (int b = 0; b < 2; ++b)
#pragma unroll
                for (int m = 0; m < 4; ++m)
#pragma unroll
                    for (int n = 0; n < 2; ++n) acc[a][b][m][n] = (f32x4){0.f, 0.f, 0.f, 0.f};
        cur = nxt; cA = nA; cB = nB; ++ui;
        if constexpr (ALIGN_EPI) { if (wr == 1) PG8_BAR; }
    }
    PG8_WAIT_V(0);
    if constexpr (!ALIGN_EPI) { if (wr == 0) PG8_BAR; }
    PG8_BAR;
    if constexpr (Epi::AFTER_DRAIN) { E.fused(acc, cur, wr, wc, fr, fq, lds, wid, lane); S.done(cur); }
#undef PG8_SA
#undef PG8_SB
#undef PG8_STAGE
#undef PG8_LDA
#undef PG8_LDB
#undef PG8_MMA
#undef PG8_WAIT_V
#undef PG8_WAIT_L
#undef PG8_BAR
#undef PG8_SCHED
}
}
#include <hip/hip_bf16.h>
namespace attn_body {
using bf16=__hip_bfloat16;
using bf16x8=__attribute__((ext_vector_type(8)))short;
using s16x4=__attribute__((ext_vector_type(4)))short;
using f32x16=__attribute__((ext_vector_type(16)))float;
using u32x4=__attribute__((ext_vector_type(4)))unsigned;
constexpr int D=64,QP=1024,KVP=256;
constexpr int NW=8,QBLK=32,QB=QBLK*NW,KVBLK=64;
__device__ __forceinline__ int crow(int r,int hi){return (r&3)+8*(r>>2)+4*hi;}
#define SBAR() __builtin_amdgcn_sched_barrier(0)
constexpr int NSLOT=3, SLOTB=8192;
constexpr int LDS_K=0, LDS_V=NSLOT*SLOTB, LDS_WS=2*NSLOT*SLOTB, LDS_OST=LDS_WS+NW*64*4, LDS_BYTES=LDS_OST+NW*4096;
constexpr float C2=0.125f*1.4426950408889634f;
__device__ __forceinline__ void glds16(const void*gsrc,unsigned lds_dst){unsigned keep;
  asm volatile("s_mov_b32 %0, m0\n\ts_mov_b32 m0, %2\n\ts_nop 0\n\tglobal_load_lds_dwordx4 %1, off\n\ts_mov_b32 m0, %0":"=&s"(keep):"v"(gsrc),"s"(lds_dst):"memory");}
__device__ __forceinline__ float max3f(float a,float b,float c){float r;asm("v_max3_f32 %0, %1, %2, %3":"=v"(r):"v"(a),"v"(b),"v"(c));return r;}
__device__ __forceinline__ float max2f(float a,float b){float r;asm("v_max_f32_e32 %0, %1, %2":"=v"(r):"v"(a),"v"(b));return r;}
__device__ __forceinline__ float fadd_s(float a,float b){float r;asm("v_add_f32_e32 %0, %1, %2":"=v"(r):"v"(a),"v"(b));return r;}
__device__ __forceinline__ float fsub_s(float a,float b){float r;asm("v_sub_f32_e32 %0, %1, %2":"=v"(r):"v"(a),"v"(b));return r;}
typedef float f32x2_t __attribute__((ext_vector_type(2))); typedef __bf16 bf16x2_t __attribute__((ext_vector_type(2)));
__device__ __forceinline__ unsigned cvtpk_s(float lo,float hi){f32x2_t v={lo,hi};bf16x2_t b=__builtin_convertvector(v,bf16x2_t);return __builtin_bit_cast(unsigned,b);}
#define WAIT_BAR(N) asm volatile("s_waitcnt vmcnt(" #N ") lgkmcnt(0)\n\ts_barrier":::"memory")

__device__ __forceinline__ void qkt(f32x16&p0,f32x16&p1,const char*Kslot,const bf16x8*qr,const f32x16&negm,int r32,int hi){
  const char*kb=Kslot+hi*1024+r32*16;
  #pragma unroll
  for(int d0=0;d0<4;++d0){
    const bf16x8 b0=*reinterpret_cast<const bf16x8*>(kb+d0*2048);
    const bf16x8 b1=*reinterpret_cast<const bf16x8*>(kb+d0*2048+512);
    if(d0==0){p0=__builtin_amdgcn_mfma_f32_32x32x16_bf16(b0,qr[0],negm,0,0,0);p1=__builtin_amdgcn_mfma_f32_32x32x16_bf16(b1,qr[0],negm,0,0,0);}
    else{p0=__builtin_amdgcn_mfma_f32_32x32x16_bf16(b0,qr[d0],p0,0,0,0);p1=__builtin_amdgcn_mfma_f32_32x32x16_bf16(b1,qr[d0],p1,0,0,0);}}
}
typedef __attribute__((address_space(3))) const char* lds_cptr;
typedef short v4i16_t __attribute__((ext_vector_type(4)));
__device__ __forceinline__ void kload8(bf16x8*kf,lds_cptr kp){
  kf[0]=*(const __attribute__((address_space(3))) bf16x8*)(kp);      kf[1]=*(const __attribute__((address_space(3))) bf16x8*)(kp+512);
  kf[2]=*(const __attribute__((address_space(3))) bf16x8*)(kp+2048); kf[3]=*(const __attribute__((address_space(3))) bf16x8*)(kp+2560);
  kf[4]=*(const __attribute__((address_space(3))) bf16x8*)(kp+4096); kf[5]=*(const __attribute__((address_space(3))) bf16x8*)(kp+4608);
  kf[6]=*(const __attribute__((address_space(3))) bf16x8*)(kp+6144); kf[7]=*(const __attribute__((address_space(3))) bf16x8*)(kp+6656);
}
__device__ __forceinline__ void kload2(bf16x8*kf,lds_cptr kp,int j){ kf[2*j]=*(const __attribute__((address_space(3))) bf16x8*)(kp+j*2048); kf[2*j+1]=*(const __attribute__((address_space(3))) bf16x8*)(kp+j*2048+512); }
__device__ __forceinline__ s16x4 vtr(lds_cptr p){ return __builtin_bit_cast(s16x4,__builtin_amdgcn_ds_read_tr16_b64_v4i16((__attribute__((address_space(3))) v4i16_t*)p)); }
__device__ __forceinline__ float rowmax(const f32x16&p0,const f32x16&p1){
  float a=max3f(p0[0],p0[1],p1[0]),b=max3f(p0[2],p0[3],p1[1]);a=max3f(a,p1[2],p1[3]);
  #pragma unroll
  for(int r=4;r<16;r+=4){a=max3f(a,p0[r],p0[r+1]);b=max3f(b,p0[r+2],p0[r+3]);a=max3f(a,p1[r],p1[r+1]);b=max3f(b,p1[r+2],p1[r+3]);}
  const float m=max2f(a,b);
  auto rr=__builtin_amdgcn_permlane32_swap(__float_as_uint(m),__float_as_uint(m),false,false);
  return max2f(__uint_as_float(rr[0]),__uint_as_float(rr[1]));
}
__device__ __forceinline__ void pv(f32x16*o,int vb,bf16x8 pa0,bf16x8 pa1,bf16x8 pa2,bf16x8 pa3){
  #pragma unroll
  for(int d0=0;d0<2;++d0){s16x4 lo[4],hi[4];
    #pragma unroll
    for(int ks=0;ks<4;++ks){
      asm volatile("ds_read_b64_tr_b16 %0,%1 offset:%c2":"=&v"(lo[ks]):"v"(vb),"i"(d0*4096+ks*1024):"memory");
      asm volatile("ds_read_b64_tr_b16 %0,%1 offset:%c2":"=&v"(hi[ks]):"v"(vb),"i"(d0*4096+ks*1024+512):"memory");}
    asm volatile("s_waitcnt lgkmcnt(0)":::"memory");SBAR();
    #define PK(k) (bf16x8){lo[k][0],lo[k][1],lo[k][2],lo[k][3],hi[k][0],hi[k][1],hi[k][2],hi[k][3]}
    o[d0]=__builtin_amdgcn_mfma_f32_32x32x16_bf16(pa0,PK(0),o[d0],0,0,0);
    o[d0]=__builtin_amdgcn_mfma_f32_32x32x16_bf16(pa1,PK(1),o[d0],0,0,0);
    o[d0]=__builtin_amdgcn_mfma_f32_32x32x16_bf16(pa2,PK(2),o[d0],0,0,0);
    o[d0]=__builtin_amdgcn_mfma_f32_32x32x16_bf16(pa3,PK(3),o[d0],0,0,0);
    #undef PK
  }
}

#ifndef ATTN_STORE16
#define ATTN_STORE16(p,v) (*(u32x4*)(p)=(v))
#endif
template<int THRL> __device__ __forceinline__ void attn_unit(const bf16*Qu,const bf16*__restrict__ Kh,const bf16*__restrict__ Vh,const int NT,bf16*Ou,const bf16*Gu,char*shm){
  const int tid=threadIdx.x,lane=tid&63,r32=lane&31,hi=lane>>5; const int wid=__builtin_amdgcn_readfirstlane(tid>>6);
  const bf16*Qw=Qu+(long)(wid*QBLK)*QP;
  const unsigned lds0=(unsigned)(uintptr_t)shm;
  float*wsf=(float*)(shm+LDS_WS)+wid*64;
  const bf16*ksrc=Kh+(long)lane*KVP+wid*8;
  const bf16*vsrc=Vh+(long)(16*(wid&3)+(lane>>2))*KVP+(wid>>2)*32+(lane&3)*8;
  const unsigned kdst=lds0+LDS_K+wid*1024, vdst=lds0+LDS_V+wid*1024;
  #define DMA_K(t,slot) glds16(ksrc+(long)(t)*KVBLK*KVP,(unsigned)__builtin_amdgcn_readfirstlane(kdst+(slot)))
  #define DMA_V(t,slot) glds16(vsrc+(long)(t)*KVBLK*KVP,(unsigned)__builtin_amdgcn_readfirstlane(vdst+(slot)))
  const int vb0=(int)(lds0+LDS_V)+((lane>>4)&1)*32+(lane&3)*8+(4*hi+((lane&15)>>2))*64;
  const char*Kbase=shm+LDS_K; bf16x8 kf[8];
  const lds_cptr shm3=(lds_cptr)shm; const lds_cptr kp0=shm3+LDS_K+hi*1024+r32*16; const lds_cptr vp0=shm3+LDS_V+((lane>>4)&1)*32+(lane&3)*8+(4*hi+((lane&15)>>2))*64;
  DMA_K(0,0);DMA_V(0,0);DMA_K(1,SLOTB);
  bf16x8 qr[4];
  #pragma unroll
  for(int d0=0;d0<4;++d0)qr[d0]=*reinterpret_cast<const bf16x8*>(&Qw[(long)r32*QP+d0*16+hi*8]);
  float mhat=0.f,l_reg=0.f;f32x16 o[2];o[0]=f32x16{};o[1]=f32x16{};f32x16 negm=f32x16{};asm volatile("":"+v"(negm));
  #define CMASK(P0,P1,t) do{}while(0)
  bool resc=false;
  #define START(P0,P1) do{ const float rm=rowmax(P0,P1); resc=false; \
    { const float dl=rm; mhat=fadd_s(mhat,dl); \
      _Pragma("unroll") for(int r=0;r<16;++r){P0[r]=fsub_s(P0[r],dl);P1[r]=fsub_s(P1[r],dl);} \
      _Pragma("unroll") for(int r=0;r<16;++r)negm[r]=-mhat; asm volatile("":"+v"(negm)); } \
    _Pragma("unroll") for(int r=0;r<16;++r)P0[r]=__builtin_amdgcn_exp2f(P0[r]); }while(0)
  #define RESC() do{ if(resc){ asm volatile("s_waitcnt lgkmcnt(0)":::"memory"); \
      _Pragma("unroll") for(int d_=0;d_<2;++d_) _Pragma("unroll") for(int r=0;r<16;++r)o[d_][r]*=wsf[crow(r,hi)]; } }while(0)
  f32x16 pA0,pA1,pB0,pB1;
  int sl_prev=0,sl_cur=0,sl_next=SLOTB;
  #define ROT() do{sl_prev=sl_cur;sl_cur=sl_next;sl_next=(sl_next==(NSLOT-1)*SLOTB)?0:sl_next+SLOTB;}while(0)
  DMA_K(2,2*SLOTB);
  WAIT_BAR(3);
  qkt(pA0,pA1,Kbase,qr,negm,r32,hi);asm volatile("s_nop 15\n\ts_nop 7":"+v"(pA0),"+v"(pA1));CMASK(pA0,pA1,0);
  START(pA0,pA1);
  _Pragma("unroll") for(int r=0;r<16;++r)pA1[r]=__builtin_amdgcn_exp2f(pA1[r]);
  WAIT_BAR(0);
  DMA_K(3,0);DMA_V(1,SLOTB);
  ROT();
  kload8(kf,kp0+sl_cur);
  WAIT_BAR(2);
  s16x4 vlo[8],vhi[8]; u32x4 pw0,pw1,pw2,pw3;
  #define PKW(P,B) cvtpk_s(P[B],P[B+1])
  #define PAF(k) __builtin_bit_cast(bf16x8,pw##k)
  #define VFR(i) (bf16x8){vlo[i][0],vlo[i][1],vlo[i][2],vlo[i][3],vhi[i][0],vhi[i][1],vhi[i][2],vhi[i][3]}
  #define PIN(x) asm volatile("":"+v"(x))
  #define MX3(a,b,c) __builtin_fmaxf(__builtin_fmaxf((a),(b)),(c))
  #define GAPA(MF,A0,A1,A2,A3,W0,W1,PW) do{ MF; sacc+=A0; sacc+=A1; sacc+=A2; sacc+=A3; PIN(sacc); W0; W1; PIN(PW); SBAR(); }while(0)
  #define EX(v) __builtin_amdgcn_exp2f(v)
  #define GAPB(MF,X,B) do{ MF; X[B]=EX(X[B]); X[B+1]=EX(X[B+1]); X[B+2]=EX(X[B+2]); X[B+3]=EX(X[B+3]); PIN(X); SBAR(); }while(0)
  #define VRD(i) do{ vlo[i]=vtr(vp_+(((i)>>2)*4096+((i)&3)*1024)); vhi[i]=vtr(vp_+(((i)>>2)*4096+((i)&3)*1024+512)); }while(0)
  #define KRD(G,j) do{ if(G){ kload2(kf,kp0+sl_next,j); SBAR(); } }while(0)
  #define STEP(C0,C1,P0,P1,t,GK,GV,GL) do{ SBAR(); \
    const lds_cptr vp_=vp0+sl_prev; \
    VRD(0); SBAR(); float sacc=(P0[0]+P0[1]); \
    GAPA(C0=__builtin_amdgcn_mfma_f32_32x32x16_bf16(kf[0],qr[0],negm,0,0,0), P0[2],P0[3],P0[4],P0[5],     pw0[0]=PKW(P0,0), pw0[1]=PKW(P0,2), pw0); \
    VRD(4); SBAR(); GAPA(C1=__builtin_amdgcn_mfma_f32_32x32x16_bf16(kf[1],qr[0],negm,0,0,0), P0[6],P0[7],P0[8],P0[9],     pw0[2]=PKW(P0,4), pw0[3]=PKW(P0,6), pw0); \
    VRD(1); SBAR(); GAPA(C0=__builtin_amdgcn_mfma_f32_32x32x16_bf16(kf[2],qr[1],C0,0,0,0),   P0[10],P0[11],P0[12],P0[13], pw1[0]=PKW(P0,8), pw1[1]=PKW(P0,10), pw1); \
    VRD(5); SBAR(); GAPA(C1=__builtin_amdgcn_mfma_f32_32x32x16_bf16(kf[3],qr[1],C1,0,0,0),   P0[14],P0[15],P1[0],P1[1],   pw1[2]=PKW(P0,12),pw1[3]=PKW(P0,14), pw1); \
    VRD(2); SBAR(); GAPA(C0=__builtin_amdgcn_mfma_f32_32x32x16_bf16(kf[4],qr[2],C0,0,0,0),   P1[2],P1[3],P1[4],P1[5],     pw2[0]=PKW(P1,0), pw2[1]=PKW(P1,2), pw2); \
    VRD(6); SBAR(); GAPA(C1=__builtin_amdgcn_mfma_f32_32x32x16_bf16(kf[5],qr[2],C1,0,0,0),   P1[6],P1[7],P1[8],P1[9],     pw2[2]=PKW(P1,4), pw2[3]=PKW(P1,6), pw2); \
    VRD(3); SBAR(); GAPA(C0=__builtin_amdgcn_mfma_f32_32x32x16_bf16(kf[6],qr[3],C0,0,0,0),   P1[10],P1[11],P1[12],P1[13], pw3[0]=PKW(P1,8), pw3[1]=PKW(P1,10), pw3); \
    VRD(7); SBAR(); GAPA(C1=__builtin_amdgcn_mfma_f32_32x32x16_bf16(kf[7],qr[3],C1,0,0,0),   P1[14],P1[15],0.f,0.f,       pw3[2]=PKW(P1,12),pw3[3]=PKW(P1,14), pw3); \
    l_reg+=sacc; \
    if(GK){DMA_K((t)+3,sl_cur);} if(GV){DMA_V((t)+1,sl_next);} \
    CMASK(C0,C1,t); \
    { float a=MX3(C0[0],C0[1],C1[0]),b=MX3(C0[2],C0[3],C1[1]); a=MX3(a,C1[2],C1[3]); \
      _Pragma("unroll") for(int r=4;r<16;r+=4){a=MX3(a,C0[r],C0[r+1]);b=MX3(b,C0[r+2],C0[r+3]);a=MX3(a,C1[r],C1[r+1]);b=MX3(b,C1[r+2],C1[r+3]);} \
      float rm=__builtin_fmaxf(a,b); { auto rr=__builtin_amdgcn_permlane32_swap(__float_as_uint(rm),__float_as_uint(rm),false,false); rm=__builtin_fmaxf(__uint_as_float(rr[0]),__uint_as_float(rr[1])); } \
      resc=false; \
      if(__builtin_expect(__any(rm>(float)THRL),0)){ const float dl=__builtin_fmaxf(rm,0.f); mhat+=dl; \
        _Pragma("unroll") for(int r=0;r<16;++r){C0[r]-=dl;C1[r]-=dl;} \
        _Pragma("unroll") for(int r=0;r<16;++r)negm[r]=-mhat; asm volatile("":"+v"(negm)); \
        const float f=__builtin_amdgcn_exp2f(-dl); l_reg*=f; if(hi==0)wsf[r32]=f; resc=true; } } \
    SBAR(); \
    GAPB(o[0]=__builtin_amdgcn_mfma_f32_32x32x16_bf16(PAF(0),VFR(0),o[0],0,0,0), C0,0); \
    GAPB(o[1]=__builtin_amdgcn_mfma_f32_32x32x16_bf16(PAF(0),VFR(4),o[1],0,0,0), C0,4); \
    KRD(GL,0); GAPB(o[0]=__builtin_amdgcn_mfma_f32_32x32x16_bf16(PAF(1),VFR(1),o[0],0,0,0), C0,8); \
    KRD(GL,1); GAPB(o[1]=__builtin_amdgcn_mfma_f32_32x32x16_bf16(PAF(1),VFR(5),o[1],0,0,0), C0,12); \
    KRD(GL,2); GAPB(o[0]=__builtin_amdgcn_mfma_f32_32x32x16_bf16(PAF(2),VFR(2),o[0],0,0,0), C1,0); \
    KRD(GL,3); GAPB(o[1]=__builtin_amdgcn_mfma_f32_32x32x16_bf16(PAF(2),VFR(6),o[1],0,0,0), C1,4); \
    GAPB(o[0]=__builtin_amdgcn_mfma_f32_32x32x16_bf16(PAF(3),VFR(3),o[0],0,0,0), C1,8); \
    GAPB(o[1]=__builtin_amdgcn_mfma_f32_32x32x16_bf16(PAF(3),VFR(7),o[1],0,0,0), C1,12); \
    }while(0)
  int t=1;
  #undef CMASK
  #define CMASK(P0,P1,t) do{}while(0)
  for(;t+5<NT;t+=2){
    STEP(pB0,pB1,pA0,pA1,t,true,true,true);     WAIT_BAR(2); RESC(); ROT();
    STEP(pA0,pA1,pB0,pB1,t+1,true,true,true);   WAIT_BAR(2); RESC(); ROT();
  }
  #undef CMASK
  #define CMASK(P0,P1,t) do{}while(0)
  #define ENDW(tt) do{ if((tt)+3<NT){WAIT_BAR(2);} else if((tt)+2<NT){WAIT_BAR(1);} else {WAIT_BAR(0);} }while(0)
  for(;t+1<NT;t+=2){
    STEP(pB0,pB1,pA0,pA1,t,(t+3<NT),(t+1<NT),(t+1<NT));       ENDW(t);   RESC(); ROT();
    STEP(pA0,pA1,pB0,pB1,t+1,(t+4<NT),(t+2<NT),(t+2<NT));     ENDW(t+1); RESC(); ROT();
  }
  STEP(pB0,pB1,pA0,pA1,NT-1,false,false,false); RESC();
  { float sacc=pB0[0]+pB0[1]; _Pragma("unroll") for(int r=2;r<16;++r)sacc+=pB0[r]; _Pragma("unroll") for(int r=0;r<16;++r)sacc+=pB1[r]; l_reg+=sacc;
    pw0=(u32x4){PKW(pB0,0),PKW(pB0,2),PKW(pB0,4),PKW(pB0,6)};pw1=(u32x4){PKW(pB0,8),PKW(pB0,10),PKW(pB0,12),PKW(pB0,14)};pw2=(u32x4){PKW(pB1,0),PKW(pB1,2),PKW(pB1,4),PKW(pB1,6)};pw3=(u32x4){PKW(pB1,8),PKW(pB1,10),PKW(pB1,12),PKW(pB1,14)};
    SBAR(); pv(o,vb0+sl_cur,PAF(0),PAF(1),PAF(2),PAF(3)); }
  #undef PKW
  #undef PAF
  #undef VFR
  #undef PIN
  #undef MX3
  #undef GAPA
  #undef GAPB
  #undef EX
  #undef VRD
  #undef KRD
  #undef STEP
  #undef ENDW
  {auto rr=__builtin_amdgcn_permlane32_swap(__float_as_uint(l_reg),__float_as_uint(l_reg),false,false);l_reg=__uint_as_float(rr[0])+__uint_as_float(rr[1]);}
  if(hi==0)wsf[32+r32]=l_reg;asm volatile("s_waitcnt lgkmcnt(0)":::"memory");
  float rli[16];
  #pragma unroll
  for(int r=0;r<16;++r)rli[r]=__builtin_amdgcn_rcpf(wsf[32+crow(r,hi)]);
  bf16*Ow=Ou+(long)(wid*QBLK)*QP; const bf16*Gw=Gu+(long)(wid*QBLK)*QP;
  { bf16*stg=(bf16*)(shm+LDS_OST)+wid*2048;
    #pragma unroll
    for(int r=0;r<16;++r){const int orow=crow(r,hi);
      #pragma unroll
      for(int d0=0;d0<2;++d0)stg[orow*64+d0*32+r32]=__float2bfloat16(o[d0][r]*rli[r]);}
    asm volatile("s_waitcnt lgkmcnt(0)":::"memory");
    #pragma unroll
    for(int i=0;i<4;++i){const int row=i*8+(lane>>3),ch=lane&7; const u32x4 v=*(const u32x4*)(stg+row*64+ch*8); const u32x4 gg=*(const u32x4*)(Gw+(long)row*QP+ch*8); u32x4 w_;
      _Pragma("unroll") for(int e_=0;e_<4;++e_){ const float a0=__uint_as_float(v[e_]<<16)*__uint_as_float(gg[e_]<<16), a1=__uint_as_float(v[e_]&0xffff0000u)*__uint_as_float(gg[e_]&0xffff0000u); w_[e_]=cvtpk_s(a0,a1); }
      ATTN_STORE16(Ow+(long)row*QP+ch*8,w_);} }
  asm volatile("s_waitcnt lgkmcnt(0)\n\ts_barrier":::"memory");
  #undef DMA_K
  #undef DMA_V
  #undef CMASK
  #undef START
  #undef RESC
  #undef ROT
}
constexpr int ATTN_LDS_BYTES=LDS_BYTES;
#undef SBAR
#undef WAIT_BAR
}
constexpr int NWAVES = 8;
constexpr int N_LAUNCHES = MK_N_LAUNCHES;
constexpr int NPHASE = 10;
constexpr int DM = 1024, MTOK = 12288, MP = 8192, NB_P = 32, L_P = 256, NB_S = 4, L_S = 1024, PAST = 256;
constexpr int N1 = 2560, N3 = 5120, KVROWS = MP + NB_S * (PAST + L_S);
constexpr float LN_EPS = 1e-5f;
constexpr size_t OUT_Y = 0, OUT_K = (size_t)MTOK * DM, OUT_V = OUT_K + (size_t)MP * 256, OUT_S = OUT_V + (size_t)MP * 256, OUT_END = OUT_S + (size_t)NB_P * 2 * 8 * 128 * 128;
constexpr size_t MiB = 1u << 20;
constexpr size_t WS_CTL = 0, CTL_ZERO_BYTES = 1 * MiB;
constexpr size_t WS_MOD = 512 * 1024;
constexpr size_t WS_ROPE = 1 * MiB;
constexpr size_t WS_W1 = 2 * MiB, WS_W2 = 7 * MiB, WS_W3 = 9 * MiB, WS_W4 = 19 * MiB;
constexpr size_t WS_A = 22 * MiB;
constexpr size_t WS_B = 46 * MiB;
constexpr size_t WS_C = 70 * MiB;
constexpr size_t WS_D = 94 * MiB;
constexpr size_t WS_KALL = 118 * MiB, WS_VALL = 125 * MiB;
constexpr size_t WS_LF = 132 * MiB;
constexpr size_t WS_KR = 180 * MiB;
constexpr size_t WS_OF = 228 * MiB;
constexpr size_t WS_END = 252 * MiB;
static_assert((size_t)KVROWS * 256 * 2 <= 7 * MiB && (size_t)MTOK * DM * 2 == 24 * MiB, "ws map");
constexpr int CW_BAR = 4096;

constexpr int RING_OFF = 0, RING_BYTES = 131072;
constexpr int LDSCTL_OFF = RING_BYTES, MISC_OFF = LDSCTL_OFF + 320;
constexpr int LDS_BYTES = 147456;
#define GAS __attribute__((address_space(1)))
#define LAS __attribute__((address_space(3)))
typedef unsigned short bf16;
typedef unsigned v4u __attribute__((ext_vector_type(4)));
typedef float f32x4 __attribute__((ext_vector_type(4)));
typedef short bf16x8 __attribute__((ext_vector_type(8)));
typedef GAS unsigned gu32;
typedef GAS unsigned long long gu64;
#define RLX_AGENT __ATOMIC_RELAXED, __HIP_MEMORY_SCOPE_AGENT
#define LDS_WAIT() asm volatile("s_waitcnt lgkmcnt(0)" ::: "memory")
#define VM_WAIT() asm volatile("s_waitcnt vmcnt(0)" ::: "memory")
__device__ __forceinline__ unsigned long long rt() { return __builtin_amdgcn_s_memrealtime(); }
__device__ __forceinline__ unsigned f2bf(float f) { unsigned u = __builtin_bit_cast(unsigned, f); return (u + 0x7fffu + ((u >> 16) & 1u)) >> 16; }
__device__ __forceinline__ unsigned pk2(float lo, float hi) { return f2bf(lo) | (f2bf(hi) << 16); }

#define XB_TMO      128
#define XB_XCNT(j)  (256  + 64 * (j))
#define XB_XSUB(j)  (1280 + 64 * (j))
#define XB_XGEN(j)  (2304 + 64 * (j))
#define XB_TOP      3328
#define XB_TOPGEN   3392
#define XCD_BAR_WORDS 3456
#define XB_SPIN_CAP (1u << 18)

__device__ __forceinline__ unsigned xb_ld(unsigned* p)              { return __hip_atomic_load(p, __ATOMIC_RELAXED, __HIP_MEMORY_SCOPE_AGENT); }
__device__ __forceinline__ unsigned xb_add(unsigned* p, unsigned v) { return __hip_atomic_fetch_add(p, v, __ATOMIC_RELAXED, __HIP_MEMORY_SCOPE_AGENT); }
__device__ __forceinline__ unsigned xb_xcc_id() { return (unsigned)__builtin_amdgcn_s_getreg((3 << 11) | 20) & 0xFu; }
#define XB_SPIN(cond, bar) do { unsigned _sp = 0; while (cond) { __builtin_amdgcn_s_sleep(1); \
    if ((++_sp & 255u) == 0u) { if (xb_ld(&(bar)[XB_TMO])) break; if (_sp > XB_SPIN_CAP) { atomicAdd(&(bar)[XB_TMO], 1u); break; } } } } while (0)

struct XcdBarrier {
    unsigned* bar; unsigned x;
    volatile LAS unsigned* st;
};

__device__ __forceinline__ XcdBarrier xcd_barrier_post(unsigned* bar, volatile LAS unsigned* st) {
    XcdBarrier b; b.bar = bar; b.x = xb_xcc_id(); b.st = st;
    if (threadIdx.x == 0) (void)xb_add(&bar[XB_XCNT(b.x)], 1u);
    return b;
}
__device__ __forceinline__ void xcd_barrier_complete(unsigned* bar, unsigned x, unsigned& nloc, unsigned& nx) {
    const unsigned G = gridDim.x * gridDim.y * gridDim.z;
    unsigned sum, cnt, mine, sp = 0u;
    for (;;) {
        sum = 0u; cnt = 0u; mine = 0u;
#pragma unroll
        for (unsigned j = 0; j < 16; ++j) { const unsigned c = xb_ld(&bar[XB_XCNT(j)]); sum += c; cnt += (c > 0u) ? 1u : 0u; mine = (j == x) ? c : mine; }
        if (sum == G) break;
        __builtin_amdgcn_s_sleep(1);
        if ((++sp & 255u) == 0u) { if (xb_ld(&bar[XB_TMO])) break; if (sp > XB_SPIN_CAP) { atomicAdd(&bar[XB_TMO], 1u); break; } }
    }
    nloc = mine > 0u ? mine : 1u; nx = cnt > 0u ? cnt : 1u;
}

__device__ __forceinline__ void xcd_barrier(const XcdBarrier& b) {
    asm volatile("s_waitcnt vmcnt(0)" ::: "memory");
    __syncthreads();
    if (threadIdx.x == 0) {
        unsigned* bar = b.bar;
        __builtin_amdgcn_s_waitcnt(0);
        unsigned nloc = b.st[0], nx = b.st[1];
        if (nloc == 0u) { xcd_barrier_complete(bar, b.x, nloc, nx); b.st[0] = nloc; b.st[1] = nx; }
        const unsigned old = xb_add(&bar[XB_XSUB(b.x)], 1u);
        const unsigned gen = old / nloc;
        if (old + 1u == (gen + 1u) * nloc) {
            __builtin_amdgcn_fence(__ATOMIC_RELEASE, "agent");
            asm volatile("s_waitcnt vmcnt(0)" ::: "memory");
            const unsigned og = xb_add(&bar[XB_TOP], 1u);
            const unsigned tg = og / nx;
            if (og + 1u == (tg + 1u) * nx) xb_add(&bar[XB_TOPGEN], 1u);
            else XB_SPIN(xb_ld(&bar[XB_TOPGEN]) == tg, bar);
            __builtin_amdgcn_fence(__ATOMIC_ACQUIRE, "agent");
            xb_add(&bar[XB_XGEN(b.x)], 1u);
            asm volatile("s_waitcnt vmcnt(0)" ::: "memory");
        } else {
            XB_SPIN(xb_ld(&bar[XB_XGEN(b.x)]) == gen, bar);
            __builtin_amdgcn_fence(__ATOMIC_ACQUIRE, "agent");
            asm volatile("s_waitcnt vmcnt(0)" ::: "memory");
        }
    }
    __syncthreads();
}
struct Frame {
    LAS unsigned char* lds;
    volatile LAS unsigned* MISC;
    gu32* ctl;
    int tid, lane, wave, vcu, G;
};
__device__ __forceinline__ float bf2f_lo(unsigned u) { return __uint_as_float(u << 16); }
__device__ __forceinline__ float bf2f_hi(unsigned u) { return __uint_as_float(u & 0xffff0000u); }
__device__ __forceinline__ float wave_sum(float v) {
#pragma unroll
    for (int o = 1; o < 64; o <<= 1) v += __shfl_xor(v, o);
    return v;
}
__device__ __forceinline__ void sincos_cw(float x, float& sn, float& cs) {
    const float kf = rintf(x * 0.63661977236758134f); const int k = (int)kf;
    float r = fmaf(-kf, 1.5707962513e+00f, x); r = fmaf(-kf, 7.5497894159e-08f, r);
    const float r2 = r * r;
    const float s = r + r * r2 * (-1.6666666667e-01f + r2 * (8.3333333333e-03f + r2 * (-1.9841269841e-04f + r2 * 2.7557319224e-06f)));
    const float c = 1.0f + r2 * (-0.5f + r2 * (4.1666666667e-02f + r2 * (-1.3888888889e-03f + r2 * (2.4801587302e-05f + r2 * -2.7557319224e-07f))));
    switch (k & 3) { case 0: sn = s; cs = c; break; case 1: sn = c; cs = -s; break; case 2: sn = -s; cs = -c; break; default: sn = -c; cs = s; break; }
}
__device__ __forceinline__ int slot_of(int mode, int n) {
    if (mode == 0) return n;
    const int t = n & ~255, L = n & 255;
    if (mode == 1 && (n >> 8) <= 4) { const int wc = L >> 6, bj = (L >> 5) & 1; return t + 128 * bj + 32 * wc + (L & 31); }
    const int hi = L & ~31, r5 = L & 31, fq = r5 >> 3, nn = (r5 >> 2) & 1, e = r5 & 3; return t + hi + 16 * nn + 4 * fq + e;
}
__device__ __forceinline__ void p0_transpose_item(const float* W, int K, int N, bf16* WT, int mode, LAS float* scr, int item, int lane) {
    const int nblk = N / 32, kb = item / nblk, nb = item % nblk, k0 = 64 * kb, n0 = 32 * nb;
#pragma unroll 8
    for (int i = 0; i < 32; ++i) { const int kk = 2 * i + (lane >> 5); scr[kk * 33 + (lane & 31)] = W[(size_t)(k0 + kk) * N + n0 + (lane & 31)]; }
    LDS_WAIT(); asm volatile("" ::: "memory");
    const int c = lane & 7;
#pragma unroll
    for (int j = 0; j < 4; ++j) { const int n = (lane >> 3) + 8 * j; const LAS float* s = scr + (8 * c) * 33 + n;
        v4u o; o.x = pk2(s[0 * 33], s[1 * 33]); o.y = pk2(s[2 * 33], s[3 * 33]); o.z = pk2(s[4 * 33], s[5 * 33]); o.w = pk2(s[6 * 33], s[7 * 33]);
        *(GAS v4u*)(WT + (size_t)slot_of(mode, n0 + n) * K + k0 + 8 * c) = o; }
    LDS_WAIT(); asm volatile("" ::: "memory");
}
struct Ptrs {
    const float *x_prompt, *x_sample, *cache_k, *cache_v, *state_rec, *c, *c_ctx, *ada_w, *ada_b, *attn_w_in, *attn_q_gain, *attn_k_gain, *attn_w_out,
                *rec_w_in, *rec_lb, *rec_norm_gain, *rec_w_out, *ln_gain, *ln_bias;
    float* out; unsigned char* ws;
};
__device__ __forceinline__ void p0_adaln_item(const Ptrs& P, float* mod, LAS float* scr, int item, int lane) {
    const int kc = item & 7, cbk = (item >> 3) % 48, l = item / (8 * 48), k0 = kc * 128, c0 = cbk * 64;
#pragma unroll
    for (int j = 0; j < 5; ++j)
#pragma unroll
        for (int t = 0; t < 2; ++t) { const int kk = lane + 64 * t; const float cv = (j == 0) ? P.c_ctx[k0 + kk] : P.c[(j - 1) * 1024 + k0 + kk]; scr[j * 128 + kk] = cv / (1.f + __expf(-cv)); }
    LDS_WAIT(); asm volatile("" ::: "memory");
    float a0 = 0.f, a1 = 0.f, a2 = 0.f, a3 = 0.f, a4 = 0.f;
    const float* w = P.ada_w + (size_t)l * 1024 * 3072 + (size_t)k0 * 3072 + c0 + lane;
#pragma unroll 8
    for (int kk = 0; kk < 128; ++kk) { const float wv = w[(size_t)kk * 3072];
        a0 += scr[kk] * wv; a1 += scr[128 + kk] * wv; a2 += scr[256 + kk] * wv; a3 += scr[384 + kk] * wv; a4 += scr[512 + kk] * wv; }
    if (kc == 0) { const float b = P.ada_b[l * 3072 + c0 + lane]; a0 += b; a1 += b; a2 += b; a3 += b; a4 += b; }
    float* mo = mod + (size_t)l * 5 * 3072 + c0 + lane;
    atomicAdd(mo, a0); atomicAdd(mo + 3072, a1); atomicAdd(mo + 2 * 3072, a2); atomicAdd(mo + 3 * 3072, a3); atomicAdd(mo + 4 * 3072, a4);
    LDS_WAIT(); asm volatile("" ::: "memory");
}
__device__ __forceinline__ void p0_prologue(Frame& F, const Ptrs& P) {
    LAS float* scr = (LAS float*)(F.lds + RING_OFF + F.wave * 16384);
    const int gw = F.vcu * NWAVES + F.wave, NGW = F.G * NWAVES;
    bf16* W1 = (bf16*)(P.ws + WS_W1); bf16* W2 = (bf16*)(P.ws + WS_W2); bf16* W3 = (bf16*)(P.ws + WS_W3); bf16* W4 = (bf16*)(P.ws + WS_W4);
    constexpr int I_1 = (DM / 64) * (N1 / 32), I_2 = (DM / 64) * (DM / 32), I_3 = (DM / 64) * (N3 / 32), I_4 = I_2, I_A = 2 * 48 * 8;
    constexpr int NITEMS = I_A + I_1 + I_2 + I_3 + I_4;
    for (int it = gw; it < NITEMS; it += NGW) {
        int r = it;
        if (r < I_A) { p0_adaln_item(P, (float*)(P.ws + WS_MOD), scr, r, F.lane); continue; } r -= I_A;
        if (r < I_1) { p0_transpose_item(P.attn_w_in, DM, N1, W1, 1, scr, r, F.lane); continue; } r -= I_1;
        if (r < I_2) { p0_transpose_item(P.attn_w_out, DM, DM, W2, 0, scr, r, F.lane); continue; } r -= I_2;
        if (r < I_3) { p0_transpose_item(P.rec_w_in, DM, N3, W3, 2, scr, r, F.lane); continue; } r -= I_3;
        p0_transpose_item(P.rec_w_out, DM, DM, W4, 0, scr, r, F.lane);
    }
    const int gt = gw * 64 + F.lane, NGT = NGW * 64;
    if (gt < 1024) { const int pos = gt >> 4, i = gt & 15; const float inv = exp2f(-(float)i * (13.287712379549449f / 16.0f)); const float ang = (float)pos * inv;
        float* tab = (float*)(P.ws + WS_ROPE); float sn, cs; sincos_cw(ang, sn, cs); tab[pos * 32 + i] = cs; tab[pos * 32 + 16 + i] = sn; }
    bf16* Kall = (bf16*)(P.ws + WS_KALL); bf16* Vall = (bf16*)(P.ws + WS_VALL);
    for (int it = gt; it < 2 * 32768; it += NGT) { const int which = it >> 15, i8 = it & 32767, b = i8 >> 13, t = (i8 >> 5) & 255, c8 = i8 & 31;
        const float* src = (which ? P.cache_v : P.cache_k) + ((size_t)(b * 256 + t) * 256 + c8 * 8);
        const f32x4 x0 = *(const GAS f32x4*)src, x1 = *(const GAS f32x4*)(src + 4);
        v4u o; o.x = pk2(x0.x, x0.y); o.y = pk2(x0.z, x0.w); o.z = pk2(x1.x, x1.y); o.w = pk2(x1.z, x1.w);
        *(GAS v4u*)((which ? Vall : Kall) + ((size_t)(MP + b * 1280 + t) * 256 + c8 * 8)) = o; }
}
__device__ __forceinline__ void p1_modulate(Frame& F, const Ptrs& P) {
    const int gw = F.vcu * NWAVES + F.wave, NGW = F.G * NWAVES;
    const float* mod = (const float*)(P.ws + WS_MOD); bf16* H = (bf16*)(P.ws + WS_A);
    for (int m = gw; m < MTOK; m += NGW) {
        const int cond = m < MP ? 0 : 1 + ((m - MP) >> 10);
        const float* xr = m < MP ? P.x_prompt + (size_t)m * DM : P.x_sample + (size_t)(m - MP) * DM;
        const float* sh = mod + (size_t)cond * 3072, *sc = sh + 1024;
        GAS unsigned long long* o8 = (GAS unsigned long long*)(H + (size_t)m * DM) + F.lane;
#pragma unroll
        for (int j = 0; j < 4; ++j) { const int c = 4 * F.lane + 256 * j; const f32x4 x = *(const GAS f32x4*)(xr + c), s = *(const GAS f32x4*)(sc + c), t = *(const GAS f32x4*)(sh + c);
            const f32x4 h = x * (s + 1.0f) + t; o8[64 * j] = (unsigned long long)pk2(h.x, h.y) | ((unsigned long long)pk2(h.z, h.w) << 32); }
    }
}
template <bool WITH_H>
__device__ __forceinline__ void p_layernorm(Frame& F, const Ptrs& P, float* Y, const float* lng, const float* lnb, const float* modl) {
    const int gw = F.vcu * NWAVES + F.wave, NGW = F.G * NWAVES; bf16* H = (bf16*)(P.ws + WS_A);
    for (int m = gw; m < MTOK; m += NGW) {
        GAS f32x4* yr = (GAS f32x4*)(Y + (size_t)m * DM) + F.lane;
        f32x4 v[4]; float s = 0.f;
#pragma unroll
        for (int j = 0; j < 4; ++j) { v[j] = yr[64 * j]; s += (v[j].x + v[j].y) + (v[j].z + v[j].w); }
        const float mean = wave_sum(s) * (1.f / DM); float s2 = 0.f;
#pragma unroll
        for (int j = 0; j < 4; ++j) { v[j] = v[j] - mean; s2 += (v[j].x * v[j].x + v[j].y * v[j].y) + (v[j].z * v[j].z + v[j].w * v[j].w); }
        const float rstd = rsqrtf(wave_sum(s2) * (1.f / DM) + LN_EPS);
        const int cond = m < MP ? 0 : 1 + ((m - MP) >> 10);
        GAS unsigned long long* o8 = (GAS unsigned long long*)(H + (size_t)m * DM) + F.lane;
#pragma unroll
        for (int j = 0; j < 4; ++j) { const int c = 4 * F.lane + 256 * j; const f32x4 g = *(const GAS f32x4*)(lng + c), b = *(const GAS f32x4*)(lnb + c);
            const f32x4 x1 = v[j] * rstd * g + b; yr[64 * j] = x1;
            if (WITH_H) { const f32x4 t = *(const GAS f32x4*)(modl + (size_t)cond * 3072 + c), sc = *(const GAS f32x4*)(modl + (size_t)cond * 3072 + 1024 + c);
                const f32x4 h = x1 * (sc + 1.0f) + t; o8[64 * j] = (unsigned long long)pk2(h.x, h.y) | ((unsigned long long)pk2(h.z, h.w) << 32); } }
    }
}
namespace gla {
typedef short bf16x8 __attribute__((ext_vector_type(8)));
typedef float f32x4 __attribute__((ext_vector_type(4)));
typedef float f32x2 __attribute__((ext_vector_type(2)));
typedef unsigned u32x2 __attribute__((ext_vector_type(2)));
typedef unsigned u32x4 __attribute__((ext_vector_type(4)));
typedef _Float16 f16x2 __attribute__((ext_vector_type(2)));
#define GLAS __attribute__((address_space(3)))
constexpr int QT_OFF = 0, QT_STR = 272, KT_OFF = 17408, KH_OFF = 34816, KH_STR = 144, VT_OFF = KH_OFF + 128 * KH_STR, AS_OFF = VT_OFF + 128 * KH_STR, AS_STR = 144,
              TOT_OFF = AS_OFF + 64 * AS_STR, EBR_OFF = TOT_OFF + 4096, EBL_OFF = EBR_OFF + 512, RS_OFF = EBL_OFF + 512, GLA_LDS_BYTES = RS_OFF + 2048;
static_assert(KT_OFF == 64 * QT_STR && KH_OFF == 2 * 64 * QT_STR && GLA_LDS_BYTES <= 131072, "gla lds map");
struct GlaT { const unsigned short *QR, *KR, *VR, *GR; const _Float16* LF; unsigned short *OF, *GO; const float* ngain; };
__device__ __forceinline__ unsigned pkbf(float lo, float hi) { typedef float f2 __attribute__((ext_vector_type(2))); typedef __bf16 b2 __attribute__((ext_vector_type(2))); f2 v = {lo, hi}; b2 b = __builtin_convertvector(v, b2); return __builtin_bit_cast(unsigned, b); }
__device__ __forceinline__ float lo2f(unsigned u) { return __uint_as_float(u << 16); }
__device__ __forceinline__ float hi2f(unsigned u) { return __uint_as_float(u & 0xffff0000u); }
template <int MODE>
__device__ __forceinline__ void scan(GLAS unsigned char* lds, const GlaT& T, const int rowbase, const int nch, const int h, const int dir, const float* s0, float* sout) {
    const int tid = threadIdx.x, lane = tid & 63, w = __builtin_amdgcn_readfirstlane(tid >> 6), g = lane >> 4, c = lane & 15;
    f32x4 S[8];
#pragma unroll
    for (int t = 0; t < 8; ++t) {
        if (s0) {
#pragma unroll
            for (int r = 0; r < 4; ++r) S[t][r] = s0[(size_t)(16 * t + 4 * g + r) * 128 + 16 * w + c];
        } else S[t] = (f32x4){0.f, 0.f, 0.f, 0.f};
    }
    const size_t colq = (size_t)h * 128 + 2 * lane;
    const unsigned short* KRd = T.KR + (size_t)dir * MTOK * 1024; const _Float16* LFd = T.LF + (size_t)dir * MTOK * 1024;
    const int dk0 = 2 * lane, pos0 = (dk0 & ~31) + 8 * ((dk0 >> 2) & 3) + 4 * ((dk0 >> 4) & 1) + (dk0 & 3);
    for (int i = 0; i < nch; ++i) {
        const int r0 = rowbase + 64 * (dir ? (nch - 1 - i) : i);
        float cs0[8], cs1[8]; unsigned qv[8], kv[8], vv[8]; float run0 = 0.f, run1 = 0.f;
#pragma unroll
        for (int ii = 0; ii < 8; ++ii) { const int p = 8 * w + ii; const size_t ro = (size_t)(r0 + (dir ? 63 - p : p)) * 1024 + colq;
            const f16x2 lf = *(const f16x2*)(LFd + ro); run0 += (float)lf.x; run1 += (float)lf.y; cs0[ii] = run0; cs1[ii] = run1;
            qv[ii] = *(const unsigned*)(T.QR + ro); kv[ii] = *(const unsigned*)(KRd + ro); vv[ii] = *(const unsigned*)(T.VR + ro); }
        *(GLAS f32x2*)(lds + TOT_OFF + (w * 128 + dk0) * 4) = (f32x2){run0, run1};
        __syncthreads();
        float pre0 = 0.f, pre1 = 0.f, br0 = 0.f, br1 = 0.f, bl0 = 0.f, bl1 = 0.f;
#pragma unroll
        for (int s = 0; s < 8; ++s) { const f32x2 t = *(const GLAS f32x2*)(lds + TOT_OFF + (s * 128 + dk0) * 4);
            if (s < w) { pre0 += t.x; pre1 += t.y; } if (s < 4) { br0 += t.x; br1 += t.y; } bl0 += t.x; bl1 += t.y; }
        const float c30 = __expf(bl0 - br0), c31 = __expf(bl1 - br1);
        if (w == 0) { *(GLAS f32x2*)(lds + EBR_OFF + dk0 * 4) = (f32x2){__expf(br0), __expf(br1)}; *(GLAS f32x2*)(lds + EBL_OFF + dk0 * 4) = (f32x2){__expf(bl0), __expf(bl1)}; }
        unsigned kh0[4], kh1[4], vt0[4], vt1[4];
#pragma unroll
        for (int ii = 0; ii < 8; ii += 2) {
            float ka[2], kb[2];
#pragma unroll
            for (int jj = 0; jj < 2; ++jj) { const int p = 8 * w + ii + jj;
                const float x0 = cs0[ii + jj] + pre0 - br0, x1 = cs1[ii + jj] + pre1 - br1;
                const float e10 = __expf(x0), e11 = __expf(x1), e20 = __expf(-x0), e21 = __expf(-x1);
                const float k0 = lo2f(kv[ii + jj]) * e20, k1 = hi2f(kv[ii + jj]) * e21;
                *(GLAS unsigned*)(lds + QT_OFF + p * QT_STR + pos0 * 2) = pkbf(lo2f(qv[ii + jj]) * e10, hi2f(qv[ii + jj]) * e11);
                *(GLAS unsigned*)(lds + KT_OFF + p * QT_STR + pos0 * 2) = pkbf(k0, k1);
                ka[jj] = k0 * c30; kb[jj] = k1 * c31; }
            kh0[ii >> 1] = pkbf(ka[0], ka[1]); kh1[ii >> 1] = pkbf(kb[0], kb[1]);
            vt0[ii >> 1] = (vv[ii] & 0xffffu) | (vv[ii + 1] << 16); vt1[ii >> 1] = (vv[ii] >> 16) | (vv[ii + 1] & 0xffff0000u);
        }
        *(GLAS u32x4*)(lds + KH_OFF + dk0 * KH_STR + 16 * w) = (u32x4){kh0[0], kh0[1], kh0[2], kh0[3]};
        *(GLAS u32x4*)(lds + KH_OFF + (dk0 + 1) * KH_STR + 16 * w) = (u32x4){kh1[0], kh1[1], kh1[2], kh1[3]};
        *(GLAS u32x4*)(lds + VT_OFF + dk0 * KH_STR + 16 * w) = (u32x4){vt0[0], vt0[1], vt0[2], vt0[3]};
        *(GLAS u32x4*)(lds + VT_OFF + (dk0 + 1) * KH_STR + 16 * w) = (u32x4){vt1[0], vt1[1], vt1[2], vt1[3]};
        __syncthreads();
        { const int ti = w >> 1;
#pragma unroll
          for (int q2 = 0; q2 < 2; ++q2) { const int si = 2 * (w & 1) + q2; f32x4 a4 = (f32x4){0.f, 0.f, 0.f, 0.f};
            if (si <= ti) {
#pragma unroll
                for (int ks = 0; ks < 4; ++ks) { const bf16x8 af = *(const GLAS bf16x8*)(lds + KT_OFF + (16 * si + c) * QT_STR + 64 * ks + 16 * g), bfr = *(const GLAS bf16x8*)(lds + QT_OFF + (16 * ti + c) * QT_STR + 64 * ks + 16 * g);
                    a4 = __builtin_amdgcn_mfma_f32_16x16x32_bf16(af, bfr, a4, 0, 0, 0); }
                if (si == ti) {
#pragma unroll
                    for (int r = 0; r < 4; ++r) if (4 * g + r > c) a4[r] = 0.f; }
            }
            *(GLAS u32x2*)(lds + AS_OFF + (16 * ti + c) * AS_STR + (16 * si + 4 * g) * 2) = (u32x2){pkbf(a4[0], a4[1]), pkbf(a4[2], a4[3])}; } }
        __syncthreads();
        bf16x8 vf[2];
#pragma unroll
        for (int sp = 0; sp < 2; ++sp) vf[sp] = *(const GLAS bf16x8*)(lds + VT_OFF + (16 * w + c) * KH_STR + 64 * sp + 16 * g);
        f32x4 o[4];
#pragma unroll
        for (int mt = 0; mt < 4; ++mt) o[mt] = (f32x4){0.f, 0.f, 0.f, 0.f};
#pragma unroll
        for (int ks = 0; ks < 4; ++ks) {
            const f32x4 eb0 = *(const GLAS f32x4*)(lds + EBR_OFF + (32 * ks + 4 * g) * 4), eb1 = *(const GLAS f32x4*)(lds + EBR_OFF + (32 * ks + 16 + 4 * g) * 4);
            const f32x4 s0v = S[2 * ks] * eb0, s1v = S[2 * ks + 1] * eb1;
            const u32x4 sw = (u32x4){pkbf(s0v[0], s0v[1]), pkbf(s0v[2], s0v[3]), pkbf(s1v[0], s1v[1]), pkbf(s1v[2], s1v[3])};
            const bf16x8 sf = __builtin_bit_cast(bf16x8, sw);
#pragma unroll
            for (int mt = 0; mt < 4; ++mt) { const bf16x8 qf = *(const GLAS bf16x8*)(lds + QT_OFF + (16 * mt + c) * QT_STR + 64 * ks + 16 * g);
                o[mt] = __builtin_amdgcn_mfma_f32_16x16x32_bf16(sf, qf, o[mt], 0, 0, 0); }
        }
#pragma unroll
        for (int mt = 0; mt < 4; ++mt)
#pragma unroll
            for (int sp = 0; sp < 2; ++sp) if (2 * sp <= mt) { const bf16x8 af = *(const GLAS bf16x8*)(lds + AS_OFF + (16 * mt + c) * AS_STR + 64 * sp + 16 * g);
                o[mt] = __builtin_amdgcn_mfma_f32_16x16x32_bf16(vf[sp], af, o[mt], 0, 0, 0); }
#pragma unroll
        for (int t = 0; t < 8; ++t) { const f32x4 ebl = *(const GLAS f32x4*)(lds + EBL_OFF + (16 * t + 4 * g) * 4); S[t] = S[t] * ebl;
#pragma unroll
            for (int sp = 0; sp < 2; ++sp) { const bf16x8 kf = *(const GLAS bf16x8*)(lds + KH_OFF + (16 * t + c) * KH_STR + 64 * sp + 16 * g);
                S[t] = __builtin_amdgcn_mfma_f32_16x16x32_bf16(kf, vf[sp], S[t], 0, 0, 0); } }
        const size_t cold = (size_t)h * 128 + 16 * w + 4 * g;
        if (MODE == 0) {
#pragma unroll
            for (int mt = 0; mt < 4; ++mt) { const int p = 16 * mt + c; const size_t ro = (size_t)(r0 + (dir ? 63 - p : p)) * 1024 + cold;
                *(u32x2*)(T.OF + ro) = (u32x2){pkbf(o[mt][0], o[mt][1]), pkbf(o[mt][2], o[mt][3])}; }
        } else {
            float ss[4];
#pragma unroll
            for (int mt = 0; mt < 4; ++mt) { const int p = 16 * mt + c; const size_t ro = (size_t)(r0 + (dir ? 63 - p : p)) * 1024 + cold;
                const u32x2 pf = *(const u32x2*)(T.OF + ro); o[mt][0] += lo2f(pf.x); o[mt][1] += hi2f(pf.x); o[mt][2] += lo2f(pf.y); o[mt][3] += hi2f(pf.y);
                float s = (o[mt][0] * o[mt][0] + o[mt][1] * o[mt][1]) + (o[mt][2] * o[mt][2] + o[mt][3] * o[mt][3]);
                s += __shfl_xor(s, 16); s += __shfl_xor(s, 32); ss[mt] = s;
                if (g == 0) *(GLAS float*)(lds + RS_OFF + (w * 64 + p) * 4) = s; }
            __syncthreads();
            const f32x4 ng = *(const f32x4*)(T.ngain + 16 * w + 4 * g);
#pragma unroll
            for (int mt = 0; mt < 4; ++mt) { const int p = 16 * mt + c; float tot = 0.f;
#pragma unroll
                for (int ww = 0; ww < 8; ++ww) tot += *(const GLAS float*)(lds + RS_OFF + (ww * 64 + p) * 4);
                const float rinv = rsqrtf(tot * (1.0f / 128.0f) + 1e-6f);
                const size_t ro = (size_t)(r0 + (dir ? 63 - p : p)) * 1024 + cold;
                const u32x2 gt = *(const u32x2*)(T.GR + ro);
                const float y0 = o[mt][0] * rinv * ng[0] * lo2f(gt.x), y1 = o[mt][1] * rinv * ng[1] * hi2f(gt.x), y2 = o[mt][2] * rinv * ng[2] * lo2f(gt.y), y3 = o[mt][3] * rinv * ng[3] * hi2f(gt.y);
                *(u32x2*)(T.GO + ro) = (u32x2){pkbf(y0, y1), pkbf(y2, y3)}; }
        }
    }
    if (sout) {
#pragma unroll
        for (int t = 0; t < 8; ++t)
#pragma unroll
            for (int r = 0; r < 4; ++r) sout[(size_t)(16 * t + 4 * g + r) * 128 + 16 * w + c] = S[t][r];
    }
}
#undef GLAS
}
struct Args { const float* in[19]; float* out; unsigned char* ws; int ph_lo, ph_hi, li, pad; };
__global__ void __launch_bounds__(NWAVES * 64, 2) mk_fwd(Args args) {
    extern __shared__ __attribute__((aligned(16))) unsigned char lds[];
    Frame F;
    F.lds = (LAS unsigned char*)lds;
    F.MISC = (volatile LAS unsigned*)(F.lds + MISC_OFF);
    F.tid = threadIdx.x; F.lane = F.tid & 63; F.wave = __builtin_amdgcn_readfirstlane(F.tid >> 6);
    F.G = gridDim.x; { const int bx = blockIdx.x; F.vcu = (F.G % 8 == 0) ? (bx % 8) * (F.G / 8) + bx / 8 : bx; }
    Ptrs P;
    P.x_prompt = args.in[0]; P.x_sample = args.in[1]; P.cache_k = args.in[2]; P.cache_v = args.in[3]; P.state_rec = args.in[4]; P.c = args.in[5]; P.c_ctx = args.in[6];
    P.ada_w = args.in[7]; P.ada_b = args.in[8]; P.attn_w_in = args.in[9]; P.attn_q_gain = args.in[10]; P.attn_k_gain = args.in[11]; P.attn_w_out = args.in[12];
    P.rec_w_in = args.in[13]; P.rec_lb = args.in[14]; P.rec_norm_gain = args.in[15]; P.rec_w_out = args.in[16]; P.ln_gain = args.in[17]; P.ln_bias = args.in[18];
    P.out = args.out; P.ws = args.ws;
    unsigned char* ws = args.ws;
    F.ctl = (gu32*)(ws + WS_CTL);
    for (int u = F.tid; u < (LDS_BYTES - LDSCTL_OFF) / 4; u += NWAVES * 64) ((LAS unsigned*)(F.lds + LDSCTL_OFF))[u] = 0u;
    __syncthreads();
    XcdBarrier bar; bar.bar = (unsigned*)(F.ctl + CW_BAR); bar.x = 0; bar.st = nullptr;
    if (N_LAUNCHES == 1) bar = xcd_barrier_post((unsigned*)(F.ctl + CW_BAR), F.MISC + 8);
#define GRID_BAR() do { if (N_LAUNCHES == 1) xcd_barrier(bar); } while (0)
    const int lo = args.ph_lo, hi = args.ph_hi;
#define IN(k) (lo <= (k) && (k) < hi)
#define BOTH(k) (IN(k) && IN((k) + 1))
    bf16* const W1 = (bf16*)(ws + WS_W1); bf16* const W2 = (bf16*)(ws + WS_W2); bf16* const W3 = (bf16*)(ws + WS_W3); bf16* const W4 = (bf16*)(ws + WS_W4);
    bf16* const HA = (bf16*)(ws + WS_A); bf16* const QB_ = (bf16*)(ws + WS_B); bf16* const GC = (bf16*)(ws + WS_C); bf16* const AOD = (bf16*)(ws + WS_D);
    bf16* const Kall = (bf16*)(ws + WS_KALL); bf16* const Vall = (bf16*)(ws + WS_VALL);
    const float* const mod = (const float*)(ws + WS_MOD);
    float* const Y = P.out + OUT_Y;

    if (IN(0)) { p0_prologue(F, P); if (BOTH(0)) GRID_BAR(); }
    if (IN(1)) { p1_modulate(F, P); if (BOTH(1)) GRID_BAR(); }
    if (IN(2)) {
        pg8::Gemm g{HA, W1, MTOK, N1, DM}; pg8::StaticOrder S; S.init(MTOK, N1, F.G, (int)blockIdx.x);
        pg8::EpiAttnIn E{QB_, Kall, Vall, GC, P.out + OUT_K, P.out + OUT_V, P.attn_q_gain, P.attn_k_gain, (const float*)(ws + WS_ROPE)};
        pg8::gemm_phase<pg8::EpiAttnIn, pg8::StaticOrder, true, true>(F.lds + RING_OFF, g, S, E);
        if (BOTH(2)) GRID_BAR();
    }
    if (IN(3)) {
        typedef attn_body::bf16 abf;
        for (int v = F.vcu; v < 256; v += F.G) {
            { const int b = v >> 6, h = (v >> 2) & 15, qb = v & 3; const size_t qo = (size_t)(MP + b * L_S + qb * 256) * DM + h * 64; const size_t ko = (size_t)(MP + b * 1280) * 256 + (h >> 2) * 64;
              attn_body::attn_unit<8>((const abf*)QB_ + qo, (const abf*)Kall + ko, (const abf*)Vall + ko, 20, (abf*)AOD + qo, (const abf*)GC + qo, (char*)lds + RING_OFF); }
#pragma unroll 1
            for (int j = 0; j < 2; ++j) { const int u = 2 * v + j, b = u >> 4, h = u & 15; const size_t qo = (size_t)(b * L_P) * DM + h * 64; const size_t ko = (size_t)(b * L_P) * 256 + (h >> 2) * 64;
              attn_body::attn_unit<8>((const abf*)QB_ + qo, (const abf*)Kall + ko, (const abf*)Vall + ko, 4, (abf*)AOD + qo, (const abf*)GC + qo, (char*)lds + RING_OFF); }
        }
        if (BOTH(3)) GRID_BAR();
    }
    if (IN(4)) {
        pg8::Gemm g{AOD, W2, MTOK, DM, DM}; pg8::StaticOrder S; S.init(MTOK, DM, F.G, (int)blockIdx.x);
        pg8::EpiRes E{P.x_prompt, P.x_sample, Y, mod + 2048};
        pg8::gemm_phase<pg8::EpiRes, pg8::StaticOrder, true, true>(F.lds + RING_OFF, g, S, E);
        if (BOTH(4)) GRID_BAR();
    }
    if (IN(5)) { p_layernorm<true>(F, P, Y, P.ln_gain, P.ln_bias, mod + 5 * 3072); if (BOTH(5)) GRID_BAR(); }
    if (IN(6)) {
        pg8::Gemm g{HA, W3, MTOK, N3, DM}; pg8::StaticOrder S; S.init(MTOK, N3, F.G, (int)blockIdx.x);
        pg8::EpiRecIn E{QB_, (bf16*)(ws + WS_KR), GC, AOD, (_Float16*)(ws + WS_LF), P.rec_lb};
        pg8::gemm_phase<pg8::EpiRecIn, pg8::StaticOrder, true, true>(F.lds + RING_OFF, g, S, E);
        if (BOTH(6)) GRID_BAR();
    }
    if (IN(7)) {
        gla::GlaT T{QB_, (const bf16*)(ws + WS_KR), GC, AOD, (const _Float16*)(ws + WS_LF), (bf16*)(ws + WS_OF), HA, P.rec_norm_gain};
        const int bx = blockIdx.x;
        if (bx < 32 || F.G < 64) {
            for (int u = bx; u < 32; u += F.G) { const int b = u >> 3, h = u & 7; const float* s0 = P.state_rec + ((size_t)(b * 2 + 0) * 8 + h) * 16384;
                gla::scan<0>(F.lds + RING_OFF, T, MP + b * L_S, L_S / 64, h, 0, s0, nullptr);
                gla::scan<1>(F.lds + RING_OFF, T, MP + b * L_S, L_S / 64, h, 1, s0 + 8 * 16384, nullptr); }
        }
        { const int first = F.G < 64 ? bx : bx - 32, stride = F.G < 64 ? F.G : F.G - 32;
          if (first >= 0) for (int u = first; u < 256; u += stride) { const int b = u >> 3, h = u & 7; float* so = P.out + OUT_S + ((size_t)(b * 2 + 0) * 8 + h) * 16384;
                gla::scan<0>(F.lds + RING_OFF, T, b * L_P, L_P / 64, h, 0, nullptr, so);
                gla::scan<1>(F.lds + RING_OFF, T, b * L_P, L_P / 64, h, 1, nullptr, so + 8 * 16384); } }
        if (BOTH(7)) GRID_BAR();
    }
    if (IN(8)) {
        pg8::Gemm g{HA, W4, MTOK, DM, DM}; pg8::StaticOrder S; S.init(MTOK, DM, F.G, (int)blockIdx.x);
        pg8::EpiRes E{Y, Y + (size_t)MP * DM, Y, mod + 5 * 3072 + 2048};
        pg8::gemm_phase<pg8::EpiRes, pg8::StaticOrder, true, true>(F.lds + RING_OFF, g, S, E);
        if (BOTH(8)) GRID_BAR();
    }
    if (IN(9)) { p_layernorm<false>(F, P, Y, P.ln_gain + DM, P.ln_bias + DM, mod); }
#undef IN
#undef BOTH
#undef GRID_BAR
}

extern "C" void kernel_launch(void* const* d_in, const int* in_sizes, int n_in, void* d_out, int out_size, void* d_ws, size_t ws_size, hipStream_t stream) {
    static int grid = 0;
    if (grid == 0) {
        if (n_in != 19 || in_sizes[0] != MP * DM || in_sizes[1] != NB_S * L_S * DM || (size_t)out_size != OUT_END || ws_size < WS_END) {
            fprintf(stderr, "kernel_launch: unexpected shapes: n_in %d in0 %d in1 %d out %d ws %zu; nothing launched\n", n_in, n_in > 0 ? in_sizes[0] : -1, n_in > 1 ? in_sizes[1] : -1, out_size, ws_size); grid = -1; return; }
        int dev = 0, cus = 0, per_cu = 0;
        if (hipGetDevice(&dev) != hipSuccess || hipDeviceGetAttribute(&cus, hipDeviceAttributeMultiprocessorCount, dev) != hipSuccess) { fprintf(stderr, "kernel_launch: device query failed\n"); grid = -1; return; }
        if (hipFuncSetAttribute((const void*)mk_fwd, hipFuncAttributeMaxDynamicSharedMemorySize, LDS_BYTES) != hipSuccess) { fprintf(stderr, "kernel_launch: hipFuncSetAttribute failed\n"); grid = -1; return; }
        if (hipOccupancyMaxActiveBlocksPerMultiprocessor(&per_cu, (const void*)mk_fwd, NWAVES * 64, LDS_BYTES) != hipSuccess || per_cu < 1)
            fprintf(stderr, "kernel_launch: note: occupancy query reports %d workgroups per CU\n", per_cu);
        (void)hipGetLastError();
        grid = cus;
    }
    if (grid < 0) return;
    if (hipMemsetAsync((char*)d_ws + WS_CTL, 0, CTL_ZERO_BYTES, stream) != hipSuccess) { fprintf(stderr, "kernel_launch: memset failed\n"); return; }
    Args a{};
    for (int i = 0; i < 19; ++i) a.in[i] = (const float*)d_in[i];
    a.out = (float*)d_out; a.ws = (unsigned char*)d_ws;
    for (int li = 0; li < N_LAUNCHES; ++li) {
        a.ph_lo = (N_LAUNCHES == 1) ? 0 : li; a.ph_hi = (N_LAUNCHES == 1) ? NPHASE : li + 1; a.li = li;
        hipLaunchKernelGGL(mk_fwd, dim3(grid), dim3(NWAVES * 64), LDS_BYTES, stream, a);
        const hipError_t le = hipPeekAtLastError();
        if (le != hipSuccess) { fprintf(stderr, "kernel_launch: launch %d failed: %s\n", li, hipGetErrorName(le)); break; }
    }
}
```

```cpp
#include <hip/hip_runtime.h>
#include <hip/hip_bf16.h>
#include <cstdio>
#include <cstdint>
#include <cmath>
#ifndef MK_N_LAUNCHES
#define MK_N_LAUNCHES 1
#endif
namespace pg8 {
#define PG8_LAS __attribute__((address_space(3)))
typedef unsigned short bf16_t;
typedef short bf16x8 __attribute__((ext_vector_type(8)));
typedef float f32x4 __attribute__((ext_vector_type(4)));
typedef unsigned u32x4 __attribute__((ext_vector_type(4)));
constexpr int BM = 256, BK = 64, HALF = 128, HTB = HALF * BK * 2  , STAGE_BYTES = 8 * HTB, NXCD = 8, WGM = 8;

__host__ __device__ __forceinline__ int lds_byte(int r, int c) { const int st = (r >> 4) * 2 + (c >> 5), rr = r & 15, cc = c & 31, ob = rr * 64 + cc * 2; return st * 1024 + (ob ^ (((ob >> 9) & 1) << 5)); }
__host__ __device__ __forceinline__ void stage_rc(int b, int& R, int& C) { const int st = b / 1024, sb = b % 1024, swz = sb ^ (((sb >> 9) & 1) << 5); R = (st >> 1) * 16 + swz / 64; C = (st & 1) * 32 + (swz % 64) / 2; }
__host__ __device__ __forceinline__ int perm32(int rho) { const int n = rho >> 4, i = rho & 15; return 8 * (i >> 2) + 4 * n + (i & 3); }

struct Unit { int pm, pn; };
struct Gemm { const bf16_t* A; const bf16_t* Bt; int M, N, K; };

struct StaticOrder {
    int nM, nN, nwg, G, c;
    __host__ __device__ void init(int M, int N, int G_, int c_) { nM = M / BM; nN = N / BM; nwg = nM * nN; G = G_; c = c_; }
    __host__ __device__ bool next(int i, Unit& u) const {
        const long L = (long)i * G + c; if (L >= nwg) return false;
        int wgid = (int)L; { const int q = nwg / NXCD, r = nwg % NXCD, xcd = wgid % NXCD, off = wgid / NXCD; wgid = (xcd < r ? xcd * (q + 1) : r * (q + 1) + (xcd - r) * q) + off; }
        const int nig = WGM * nN, gid = wgid / nig, fm = gid * WGM, gsz = (nM - fm) < WGM ? (nM - fm) : WGM;
        u.pm = fm + ((wgid % nig) % gsz); u.pn = (wgid % nig) / gsz; return true;
    }
    __device__ __forceinline__ void a_ready(const Unit&) const {}
    __device__ __forceinline__ void done(const Unit&) const {}
};
__device__ __forceinline__ unsigned cvt_pk_bf16(float lo, float hi) { unsigned r; asm volatile("v_cvt_pk_bf16_f32 %0, %1, %2" : "=v"(r) : "v"(lo), "v"(hi)); return r; }
typedef unsigned u32x2 __attribute__((ext_vector_type(2)));
typedef _Float16 f16x8 __attribute__((ext_vector_type(8)));
__device__ __forceinline__ float siluf(float x) { return x / (1.f + __expf(-x)); }
__device__ __forceinline__ u32x2 pk4(const f32x4 x) { u32x2 w; w.x = cvt_pk_bf16(x[0], x[1]); w.y = cvt_pk_bf16(x[2], x[3]); return w; }
__device__ __forceinline__ u32x4 pk8(const f32x4 a, const f32x4 b) { u32x4 w; w.x = cvt_pk_bf16(a[0], a[1]); w.y = cvt_pk_bf16(a[2], a[3]); w.z = cvt_pk_bf16(b[0], b[1]); w.w = cvt_pk_bf16(b[2], b[3]); return w; }
constexpr float ATT_C2 = 0.125f * 1.4426950408889634f;
constexpr int MROWS = 12288, MPROMPT = 8192;
struct EpiAttnIn {
    static constexpr bool PERM = false, AFTER_DRAIN = false;
    bf16_t *Q, *Kall, *Vall, *G; float *outK, *outV; const float *qgain, *kgain, *rope;
    __device__ __forceinline__ void operator()(const f32x4 (&acc)[2][2][4][2], const Unit& u, int wr, int wc, int fr, int fq) const {
        const int pn = u.pn; const bool samp = u.pm >= 32;
        const int rbase = u.pm * BM + wr * 64 + fr;
        if (pn <= 4) {
            const bool isq = pn < 4; const float* gain = isq ? qgain : kgain;
            f32x4 gv[2][2];
#pragma unroll
            for (int bj = 0; bj < 2; ++bj)
#pragma unroll
                for (int n = 0; n < 2; ++n) gv[bj][n] = *(const f32x4*)(gain + 32 * bj + 16 * n + 4 * fq);
#pragma unroll
            for (int ai = 0; ai < 2; ++ai)
#pragma unroll
                for (int m = 0; m < 4; ++m) {
                    const int r = rbase + ai * HALF + m * 16;
                    f32x4 v[2][2]; float ss = 0.f;
#pragma unroll
                    for (int bj = 0; bj < 2; ++bj)
#pragma unroll
                        for (int n = 0; n < 2; ++n) { const f32x4 x = acc[ai][bj][m][n]; v[bj][n] = x; ss += (x[0] * x[0] + x[1] * x[1]) + (x[2] * x[2] + x[3] * x[3]); }
                    ss += __shfl_xor(ss, 16); ss += __shfl_xor(ss, 32);
                    const float rinv = rsqrtf(ss * (1.0f / 64.0f) + 1e-6f);
#pragma unroll
                    for (int bj = 0; bj < 2; ++bj)
#pragma unroll
                        for (int n = 0; n < 2; ++n) v[bj][n] = v[bj][n] * rinv * gv[bj][n];
                    int krow = r;
                    if (samp) {
                        const int rs = r - MPROMPT, t = rs & 1023, b = rs >> 10; krow = MPROMPT + b * 1280 + 256 + t;
#pragma unroll
                        for (int bj = 0; bj < 2; ++bj) { const int pos = bj ? (t & 63) : (t >> 6);
                            const f32x4 cs = *(const f32x4*)(rope + pos * 32 + 4 * fq), sn = *(const f32x4*)(rope + pos * 32 + 16 + 4 * fq);
                            const f32x4 a = v[bj][0], b2 = v[bj][1]; v[bj][0] = a * cs - b2 * sn; v[bj][1] = b2 * cs + a * sn; }
                    }
                    if (isq) { bf16_t* dst = Q + (size_t)r * 1024 + pn * 256 + wc * 64 + 4 * fq;
#pragma unroll
                        for (int bj = 0; bj < 2; ++bj)
#pragma unroll
                            for (int n = 0; n < 2; ++n) *(u32x2*)(dst + 32 * bj + 16 * n) = pk4(v[bj][n] * ATT_C2);
                    } else {
                        if (!samp) { float* dk = outK + (size_t)r * 256 + wc * 64 + 4 * fq;
#pragma unroll
                            for (int bj = 0; bj < 2; ++bj)
#pragma unroll
                                for (int n = 0; n < 2; ++n) *(f32x4*)(dk + 32 * bj + 16 * n) = v[bj][n]; }
                        bf16_t* dst = Kall + (size_t)krow * 256 + wc * 64 + 4 * fq;
#pragma unroll
                        for (int bj = 0; bj < 2; ++bj)
#pragma unroll
                            for (int n = 0; n < 2; ++n) *(u32x2*)(dst + 32 * bj + 16 * n) = pk4(v[bj][n]);
                    }
                }
        } else if (pn == 5) {
#pragma unroll
            for (int ai = 0; ai < 2; ++ai)
#pragma unroll
                for (int m = 0; m < 4; ++m) {
                    const int r = rbase + ai * HALF + m * 16; int vrow = r;
                    if (samp) { const int rs = r - MPROMPT; vrow = MPROMPT + (rs >> 10) * 1280 + 256 + (rs & 1023); }
#pragma unroll
                    for (int bj = 0; bj < 2; ++bj) { const int L = 128 * bj + 32 * wc + 8 * fq; const f32x4 x0 = acc[ai][bj][m][0], x1 = acc[ai][bj][m][1];
                        if (!samp) { *(f32x4*)(outV + (size_t)r * 256 + L) = x0; *(f32x4*)(outV + (size_t)r * 256 + L + 4) = x1; }
                        *(u32x4*)(Vall + (size_t)vrow * 256 + L) = pk8(x0, x1); }
                }
        } else {
#pragma unroll
            for (int ai = 0; ai < 2; ++ai)
#pragma unroll
                for (int m = 0; m < 4; ++m) {
                    const int r = rbase + ai * HALF + m * 16;
#pragma unroll
                    for (int bj = 0; bj < 2; ++bj) { f32x4 x0 = acc[ai][bj][m][0], x1 = acc[ai][bj][m][1];
#pragma unroll
                        for (int e = 0; e < 4; ++e) { x0[e] = siluf(x0[e]); x1[e] = siluf(x1[e]); }
                        *(u32x4*)(G + (size_t)r * 1024 + (pn - 6) * 256 + 128 * bj + 32 * wc + 8 * fq) = pk8(x0, x1); }
                }
        }
    }
};
struct EpiRes {
    static constexpr bool PERM = false, AFTER_DRAIN = false;
    const float *xp, *xs; float* Y; const float* gate;
    __device__ __forceinline__ void operator()(const f32x4 (&acc)[2][2][4][2], const Unit& u, int wr, int wc, int fr, int fq) const {
        const int cond = u.pm < 32 ? 0 : 1 + ((u.pm - 32) >> 2);
        const int col0 = u.pn * BM + wc * 32 + 4 * fq, rbase = u.pm * BM + wr * 64 + fr;
        f32x4 g4[2][2];
#pragma unroll
        for (int bj = 0; bj < 2; ++bj)
#pragma unroll
            for (int n = 0; n < 2; ++n) g4[bj][n] = *(const f32x4*)(gate + cond * 3072 + col0 + bj * HALF + n * 16);
#pragma unroll
        for (int ai = 0; ai < 2; ++ai)
#pragma unroll
            for (int m = 0; m < 4; ++m) {
                const int r = rbase + ai * HALF + m * 16;
                const float* xr = (r < MPROMPT ? xp + (size_t)r * 1024 : xs + (size_t)(r - MPROMPT) * 1024) + col0;
                float* yr = Y + (size_t)r * 1024 + col0;
#pragma unroll
                for (int bj = 0; bj < 2; ++bj)
#pragma unroll
                    for (int n = 0; n < 2; ++n) { const f32x4 x = *(const f32x4*)(xr + bj * HALF + n * 16); *(f32x4*)(yr + bj * HALF + n * 16) = x * 1.41421356237f + g4[bj][n] * acc[ai][bj][m][n]; }
            }
    }
};
struct EpiRecIn {
    static constexpr bool PERM = false, AFTER_DRAIN = false;
    bf16_t *QR, *KR, *VR, *GR; _Float16* LF; const float* rlb;
    __device__ __forceinline__ void operator()(const f32x4 (&acc)[2][2][4][2], const Unit& u, int wr, int wc, int fr, int fq) const {
        const int type = u.pn >> 2, cb = (u.pn & 3) * 256 + 32 * wc + 8 * fq, rbase = u.pm * BM + wr * 64 + fr;
        if (type == 1 || type == 2) {
            const int d = type - 1; f32x4 oml[2][2];
#pragma unroll
            for (int bj = 0; bj < 2; ++bj)
#pragma unroll
                for (int n = 0; n < 2; ++n) { const f32x4 r0 = *(const f32x4*)(rlb + (0 * 2 + d) * 1024 + cb + 128 * bj + 4 * n), r1 = *(const f32x4*)(rlb + (1 * 2 + d) * 1024 + cb + 128 * bj + 4 * n);
#pragma unroll
                    for (int e = 0; e < 4; ++e) oml[bj][n][e] = 1.f - 1.f / (1.f + __expf(r0[e] - r1[e])); }
#pragma unroll
            for (int ai = 0; ai < 2; ++ai)
#pragma unroll
                for (int m = 0; m < 4; ++m) {
                    const size_t ro = ((size_t)d * MROWS + (rbase + ai * HALF + m * 16)) * 1024 + cb;
#pragma unroll
                    for (int bj = 0; bj < 2; ++bj) { f32x4 k0, k1; f16x8 lf;
#pragma unroll
                        for (int e = 0; e < 4; ++e) { k0[e] = oml[bj][0][e] / (1.f + __expf(acc[ai][bj][m][0][e])); k1[e] = oml[bj][1][e] / (1.f + __expf(acc[ai][bj][m][1][e]));
                            lf[e] = (_Float16)__log2f(1.f - k0[e]); lf[4 + e] = (_Float16)__log2f(1.f - k1[e]); }
                        *(f16x8*)(LF + ro + 128 * bj) = lf; *(u32x4*)(KR + ro + 128 * bj) = pk8(k0, k1); }
                }
        } else if (type == 0) { plain<true>(QR, acc, rbase, cb);
        } else if (type == 3) { plain<false>(VR, acc, rbase, cb);
        } else { plain<true>(GR, acc, rbase, cb); }
    }
    template <bool ACT> __device__ __forceinline__ void plain(bf16_t* dstb, const f32x4 (&acc)[2][2][4][2], int rbase, int cb) const {
#pragma unroll
        for (int ai = 0; ai < 2; ++ai)
#pragma unroll
            for (int m = 0; m < 4; ++m) {
                const size_t ro = (size_t)(rbase + ai * HALF + m * 16) * 1024 + cb;
#pragma unroll
                for (int bj = 0; bj < 2; ++bj) { f32x4 x0 = acc[ai][bj][m][0], x1 = acc[ai][bj][m][1];
                    if (ACT) {
#pragma unroll
                        for (int e = 0; e < 4; ++e) { x0[e] = siluf(x0[e]); x1[e] = siluf(x1[e]); } }
                    *(u32x4*)(dstb + ro + 128 * bj) = pk8(x0, x1); }
            }
    }
};
template <class Epi, class Sched, bool ALIGN_EPI = false, bool SP2 = false>
__device__ __forceinline__ void gemm_phase(PG8_LAS unsigned char* lds, const Gemm g, const Sched& S, const Epi& E) {
    int tid_ = threadIdx.x; asm volatile("" : "+v"(tid_));
    const int tid = tid_, wid = __builtin_amdgcn_readfirstlane(tid >> 6), lane = tid & 63, wr = wid >> 2, wc = wid & 3, fr = lane & 15, fq = lane >> 4;
    const int K = g.K, nt = K / BK;
    unsigned voffA[2], voffB[2];
#pragma unroll
    for (int i = 0; i < 2; ++i) { int R, C; stage_rc(tid * 16 + i * 8192, R, C); const int Rb = Epi::PERM ? ((R & ~31) + perm32(R & 31)) : R;
        voffA[i] = (unsigned)(R * K + C) * 2u; voffB[i] = (unsigned)(Rb * K + C) * 2u; }
    const size_t kstep = (size_t)(BK * 2);
    const size_t hstep = (size_t)HALF * K * 2;
    const size_t tstep = 2 * hstep;
    const unsigned ldsw = (unsigned)wid * 1024u;
    const int aoff = lds_byte(wr * 64 + fr, fq * 8), boff = lds_byte(wc * 32 + fr, fq * 8);
#define PG8_SA(b, h) (((b) * 2 + (h)) * HTB)
#define PG8_SB(b, h) ((4 + (b) * 2 + (h)) * HTB)
#define PG8_STAGE(bufoff, gbase, voff) do { _Pragma("unroll") for (int _i = 0; _i < 2; ++_i) \
        __builtin_amdgcn_global_load_lds((const unsigned*)((const char*)(gbase) + (voff)[_i]), (PG8_LAS unsigned*)(lds + (bufoff) + ldsw + _i * 8192), 16, 0, 0); } while (0)
#define PG8_LDA(dst, b, h) do { _Pragma("unroll") for (int m = 0; m < 4; ++m) _Pragma("unroll") for (int k = 0; k < 2; ++k) dst[m][k] = *(const PG8_LAS bf16x8*)(lds + PG8_SA(b, h) + aoff + m * 2048 + k * 1024); } while (0)
#define PG8_LDB(dst, b, h) do { _Pragma("unroll") for (int n = 0; n < 2; ++n) _Pragma("unroll") for (int k = 0; k < 2; ++k) dst[n][k] = *(const PG8_LAS bf16x8*)(lds + PG8_SB(b, h) + boff + n * 2048 + k * 1024); } while (0)
#define PG8_MMA(ai, bj, At, Bt) do { __builtin_amdgcn_s_setprio(1); _Pragma("unroll") for (int m = 0; m < 4; ++m) _Pragma("unroll") for (int n = 0; n < 2; ++n) _Pragma("unroll") for (int k = 0; k < 2; ++k) \
        acc[ai][bj][m][n] = __builtin_amdgcn_mfma_f32_16x16x32_bf16(Bt[n][k], At[m][k], acc[ai][bj][m][n], 0, 0, 0); __builtin_amdgcn_s_setprio(0); } while (0)
#define PG8_WAIT_V(n) asm volatile("s_waitcnt vmcnt(" #n ")" ::: "memory")
#define PG8_WAIT_L(n) asm volatile("s_waitcnt lgkmcnt(" #n ")" ::: "memory")
#define PG8_BAR __builtin_amdgcn_s_barrier()
#define PG8_SCHED __builtin_amdgcn_sched_barrier(0)
    Unit cur, nxt; int ui = 0;
    if (!S.next(0, cur)) return;
    f32x4 acc[2][2][4][2];
#pragma unroll
    for (int a = 0; a < 2; ++a)
#pragma unroll
        for (int b = 0; b < 2; ++b)
#pragma unroll
            for (int m = 0; m < 4; ++m)
#pragma unroll
                for (int n = 0; n < 2; ++n) acc[a][b][m][n] = (f32x4){0.f, 0.f, 0.f, 0.f};
    bf16x8 At[4][2], B0[2][2], B1[2][2];
    const char* cA = (const char*)g.A + (size_t)cur.pm * tstep; const char* cB = (const char*)g.Bt + (size_t)cur.pn * tstep;
    S.a_ready(cur);
    if constexpr (SP2) {
        PG8_STAGE(PG8_SB(0, 0), cB, voffB); PG8_STAGE(PG8_SB(0, 1), cB + hstep, voffB); PG8_STAGE(PG8_SA(0, 0), cA, voffA); PG8_STAGE(PG8_SA(0, 1), cA + hstep, voffA);
        if (wr == 1) PG8_BAR;
        PG8_WAIT_V(2); PG8_BAR;
        PG8_STAGE(PG8_SB(1, 0), cB + kstep, voffB); PG8_STAGE(PG8_SA(1, 0), cA + kstep, voffA); PG8_STAGE(PG8_SB(1, 1), cB + hstep + kstep, voffB);
        PG8_WAIT_V(6); PG8_BAR;
    } else {
        PG8_STAGE(PG8_SB(0, 0), cB, voffB); PG8_STAGE(PG8_SA(0, 0), cA, voffA); PG8_STAGE(PG8_SB(0, 1), cB + hstep, voffB); PG8_STAGE(PG8_SA(0, 1), cA + hstep, voffA);
        if (wr == 1) PG8_BAR;
        PG8_WAIT_V(4); PG8_BAR;
        PG8_STAGE(PG8_SB(1, 0), cB + kstep, voffB); PG8_STAGE(PG8_SA(1, 0), cA + kstep, voffA); PG8_STAGE(PG8_SB(1, 1), cB + hstep + kstep, voffB);
        PG8_WAIT_V(6); PG8_BAR;
    }
    for (;;) {
        const bool has_next = S.next(ui + 1, nxt);
        const char* nA = has_next ? (const char*)g.A + (size_t)nxt.pm * tstep : cA; const char* nB = has_next ? (const char*)g.Bt + (size_t)nxt.pn * tstep : cB;
        for (int t = 0; t < nt; t += 2) {
            const bool last = (t == nt - 2);
            const char* a1 = cA + (size_t)(t + 1) * kstep;
            const char* a2 = last ? nA : cA + (size_t)(t + 2) * kstep; const char* b2 = last ? nB : cB + (size_t)(t + 2) * kstep;
            const char* a3 = a2 + kstep; const char* b3 = b2 + kstep;
            if (last && has_next) S.a_ready(nxt);
            if constexpr (SP2) {
            PG8_LDB(B0, 0, 0); PG8_LDB(B1, 0, 1); PG8_SCHED; PG8_LDA(At, 0, 0); PG8_STAGE(PG8_SA(1, 1), a1 + hstep, voffA);
            PG8_WAIT_V(8); PG8_WAIT_L(0); PG8_BAR; PG8_MMA(0, 0, At, B0); PG8_MMA(0, 1, At, B1); PG8_BAR; PG8_SCHED;
            PG8_LDA(At, 0, 1); PG8_STAGE(PG8_SB(0, 0), b2, voffB); PG8_STAGE(PG8_SB(0, 1), b2 + hstep, voffB); PG8_STAGE(PG8_SA(0, 0), a2, voffA);
            PG8_WAIT_V(8); PG8_WAIT_L(0); PG8_BAR; PG8_MMA(1, 0, At, B0); PG8_MMA(1, 1, At, B1); PG8_BAR; PG8_SCHED;
            PG8_LDB(B0, 1, 0); PG8_LDB(B1, 1, 1); PG8_SCHED; PG8_LDA(At, 1, 0); PG8_STAGE(PG8_SA(0, 1), a2 + hstep, voffA);
            PG8_WAIT_V(8); PG8_WAIT_L(0); PG8_BAR; PG8_MMA(0, 0, At, B0); PG8_MMA(0, 1, At, B1); PG8_BAR; PG8_SCHED;
            PG8_LDA(At, 1, 1); PG8_STAGE(PG8_SB(1, 0), b3, voffB); PG8_STAGE(PG8_SB(1, 1), b3 + hstep, voffB); PG8_STAGE(PG8_SA(1, 0), a3, voffA);
            PG8_WAIT_V(8); PG8_WAIT_L(0); PG8_BAR; PG8_MMA(1, 0, At, B0); PG8_MMA(1, 1, At, B1); PG8_BAR; PG8_SCHED;
            } else {
            PG8_LDB(B0, 0, 0); PG8_SCHED; PG8_LDA(At, 0, 0); PG8_STAGE(PG8_SA(1, 1), a1 + hstep, voffA);
            PG8_WAIT_L(8); PG8_BAR; PG8_WAIT_L(0); PG8_MMA(0, 0, At, B0); PG8_BAR; PG8_SCHED;
            PG8_LDB(B1, 0, 1); PG8_STAGE(PG8_SB(0, 0), b2, voffB);
            PG8_BAR; PG8_WAIT_L(0); PG8_MMA(0, 1, At, B1); PG8_BAR;
            PG8_LDA(At, 0, 1); PG8_STAGE(PG8_SA(0, 0), a2, voffA);
            PG8_BAR; PG8_WAIT_L(0); PG8_MMA(1, 0, At, B0); PG8_BAR; PG8_SCHED;
            PG8_STAGE(PG8_SB(0, 1), b2 + hstep, voffB);
            PG8_WAIT_V(6); PG8_BAR; PG8_MMA(1, 1, At, B1); PG8_BAR;
            PG8_LDB(B0, 1, 0); PG8_SCHED; PG8_LDA(At, 1, 0); PG8_STAGE(PG8_SA(0, 1), a2 + hstep, voffA);
            PG8_WAIT_L(8); PG8_BAR; PG8_WAIT_L(0); PG8_MMA(0, 0, At, B0); PG8_BAR; PG8_SCHED;
            PG8_LDB(B1, 1, 1); PG8_STAGE(PG8_SB(1, 0), b3, voffB);
            PG8_BAR; PG8_WAIT_L(0); PG8_MMA(0, 1, At, B1); PG8_BAR;
            PG8_LDA(At, 1, 1); PG8_STAGE(PG8_SA(1, 0), a3, voffA);
            PG8_BAR; PG8_WAIT_L(0); PG8_MMA(1, 0, At, B0); PG8_BAR; PG8_SCHED;
            PG8_STAGE(PG8_SB(1, 1), b3 + hstep, voffB);
            PG8_WAIT_V(6); PG8_BAR; PG8_MMA(1, 1, At, B1); PG8_BAR;
            }
        }
        if constexpr (ALIGN_EPI) { if (wr == 0) PG8_BAR; }
        if constexpr (!Epi::AFTER_DRAIN) { E(acc, cur, wr, wc, fr, fq); S.done(cur); }
        if (!has_next) break;
#pragma unroll
        for (int a = 0; a < 2; ++a)
#pragma unroll
            for (int b = 0; b < 2; ++b)
#pragma unroll
                for (int m = 0; m < 4; ++m)
#pragma unroll
                    for (int n = 0; n < 2; ++n) acc[a][b][m][n] = (f32x4){0.f, 0.f, 0.f, 0.f};
        cur = nxt; cA = nA; cB = nB; ++ui;
        if constexpr (ALIGN_EPI) { if (wr == 1) PG8_BAR; }
    }
    PG8_WAIT_V(0);
    if constexpr (!ALIGN_EPI) { if (wr == 0) PG8_BAR; }
    PG8_BAR;
    if constexpr (Epi::AFTER_DRAIN) { E.fused(acc, cur, wr, wc, fr, fq, lds, wid, lane); S.done(cur); }
#undef PG8_SA
#undef PG8_SB
#undef PG8_STAGE
#undef PG8_LDA
#undef PG8_LDB
#undef PG8_MMA
#undef PG8_WAIT_V
#undef PG8_WAIT_L
#undef PG8_BAR
#undef PG8_SCHED
}
}
#include <hip/hip_bf16.h>
namespace attn_body {
using bf16=__hip_bfloat16;
using bf16x8=__attribute__((ext_vector_type(8)))short;
using s16x4=__attribute__((ext_vector_type(4)))short;
using f32x16=__attribute__((ext_vector_type(16)))float;
using u32x4=__attribute__((ext_vector_type(4)))unsigned;
constexpr int D=64,QP=1024,KVP=256;
constexpr int NW=8,QBLK=32,QB=QBLK*NW,KVBLK=64;
__device__ __forceinline__ int crow(int r,int hi){return (r&3)+8*(r>>2)+4*hi;}
#define SBAR() __builtin_amdgcn_sched_barrier(0)
constexpr int NSLOT=3, SLOTB=8192;
constexpr int LDS_K=0, LDS_V=NSLOT*SLOTB, LDS_WS=2*NSLOT*SLOTB, LDS_OST=LDS_WS+NW*64*4, LDS_BYTES=LDS_OST+NW*4096;
constexpr float C2=0.125f*1.4426950408889634f;
__device__ __forceinline__ void glds16(const void*gsrc,unsigned lds_dst){unsigned keep;
  asm volatile("s_mov_b32 %0, m0\n\ts_mov_b32 m0, %2\n\ts_nop 0\n\tglobal_load_lds_dwordx4 %1, off\n\ts_mov_b32 m0, %0":"=&s"(keep):"v"(gsrc),"s"(lds_dst):"memory");}
__device__ __forceinline__ float max3f(float a,float b,float c){float r;asm("v_max3_f32 %0, %1, %2, %3":"=v"(r):"v"(a),"v"(b),"v"(c));return r;}
__device__ __forceinline__ float max2f(float a,float b){float r;asm("v_max_f32_e32 %0, %1, %2":"=v"(r):"v"(a),"v"(b));return r;}
__device__ __forceinline__ float fadd_s(float a,float b){float r;asm("v_add_f32_e32 %0, %1, %2":"=v"(r):"v"(a),"v"(b));return r;}
__device__ __forceinline__ float fsub_s(float a,float b){float r;asm("v_sub_f32_e32 %0, %1, %2":"=v"(r):"v"(a),"v"(b));return r;}
typedef float f32x2_t __attribute__((ext_vector_type(2))); typedef __bf16 bf16x2_t __attribute__((ext_vector_type(2)));
__device__ __forceinline__ unsigned cvtpk_s(float lo,float hi){f32x2_t v={lo,hi};bf16x2_t b=__builtin_convertvector(v,bf16x2_t);return __builtin_bit_cast(unsigned,b);}
#define WAIT_BAR(N) asm volatile("s_waitcnt vmcnt(" #N ") lgkmcnt(0)\n\ts_barrier":::"memory")

__device__ __forceinline__ void qkt(f32x16&p0,f32x16&p1,const char*Kslot,const bf16x8*qr,const f32x16&negm,int r32,int hi){
  const char*kb=Kslot+hi*1024+r32*16;
  #pragma unroll
  for(int d0=0;d0<4;++d0){
    const bf16x8 b0=*reinterpret_cast<const bf16x8*>(kb+d0*2048);
    const bf16x8 b1=*reinterpret_cast<const bf16x8*>(kb+d0*2048+512);
    if(d0==0){p0=__builtin_amdgcn_mfma_f32_32x32x16_bf16(b0,qr[0],negm,0,0,0);p1=__builtin_amdgcn_mfma_f32_32x32x16_bf16(b1,qr[0],negm,0,0,0);}
    else{p0=__builtin_amdgcn_mfma_f32_32x32x16_bf16(b0,qr[d0],p0,0,0,0);p1=__builtin_amdgcn_mfma_f32_32x32x16_bf16(b1,qr[d0],p1,0,0,0);}}
}
typedef __attribute__((address_space(3))) const char* lds_cptr;
typedef short v4i16_t __attribute__((ext_vector_type(4)));
__device__ __forceinline__ void kload8(bf16x8*kf,lds_cptr kp){
  kf[0]=*(const __attribute__((address_space(3))) bf16x8*)(kp);      kf[1]=*(const __attribute__((address_space(3))) bf16x8*)(kp+512);
  kf[2]=*(const __attribute__((address_space(3))) bf16x8*)(kp+2048); kf[3]=*(const __attribute__((address_space(3))) bf16x8*)(kp+2560);
  kf[4]=*(const __attribute__((address_space(3))) bf16x8*)(kp+4096); kf[5]=*(const __attribute__((address_space(3))) bf16x8*)(kp+4608);
  kf[6]=*(const __attribute__((address_space(3))) bf16x8*)(kp+6144); kf[7]=*(const __attribute__((address_space(3))) bf16x8*)(kp+6656);
}
__device__ __forceinline__ void kload2(bf16x8*kf,lds_cptr kp,int j){ kf[2*j]=*(const __attribute__((address_space(3))) bf16x8*)(kp+j*2048); kf[2*j+1]=*(const __attribute__((address_space(3))) bf16x8*)(kp+j*2048+512); }
__device__ __forceinline__ s16x4 vtr(lds_cptr p){ return __builtin_bit_cast(s16x4,__builtin_amdgcn_ds_read_tr16_b64_v4i16((__attribute__((address_space(3))) v4i16_t*)p)); }
__device__ __forceinline__ float rowmax(const f32x16&p0,const f32x16&p1){
  float a=max3f(p0[0],p0[1],p1[0]),b=max3f(p0[2],p0[3],p1[1]);a=max3f(a,p1[2],p1[3]);
  #pragma unroll
  for(int r=4;r<16;r+=4){a=max3f(a,p0[r],p0[r+1]);b=max3f(b,p0[r+2],p0[r+3]);a=max3f(a,p1[r],p1[r+1]);b=max3f(b,p1[r+2],p1[r+3]);}
  const float m=max2f(a,b);
  auto rr=__builtin_amdgcn_permlane32_swap(__float_as_uint(m),__float_as_uint(m),false,false);
  return max2f(__uint_as_float(rr[0]),__uint_as_float(rr[1]));
}
__device__ __forceinline__ void pv(f32x16*o,int vb,bf16x8 pa0,bf16x8 pa1,bf16x8 pa2,bf16x8 pa3){
  #pragma unroll
  for(int d0=0;d0<2;++d0){s16x4 lo[4],hi[4];
    #pragma unroll
    for(int ks=0;ks<4;++ks){
      asm volatile("ds_read_b64_tr_b16 %0,%1 offset:%c2":"=&v"(lo[ks]):"v"(vb),"i"(d0*4096+ks*1024):"memory");
      asm volatile("ds_read_b64_tr_b16 %0,%1 offset:%c2":"=&v"(hi[ks]):"v"(vb),"i"(d0*4096+ks*1024+512):"memory");}
    asm volatile("s_waitcnt lgkmcnt(0)":::"memory");SBAR();
    #define PK(k) (bf16x8){lo[k][0],lo[k][1],lo[k][2],lo[k][3],hi[k][0],hi[k][1],hi[k][2],hi[k][3]}
    o[d0]=__builtin_amdgcn_mfma_f32_32x32x16_bf16(pa0,PK(0),o[d0],0,0,0);
    o[d0]=__builtin_amdgcn_mfma_f32_32x32x16_bf16(pa1,PK(1),o[d0],0,0,0);
    o[d0]=__builtin_amdgcn_mfma_f32_32x32x16_bf16(pa2,PK(2),o[d0],0,0,0);
    o[d0]=__builtin_amdgcn_mfma_f32_32x32x16_bf16(pa3,PK(3),o[d0],0,0,0);
    #undef PK
  }
}

#ifndef ATTN_STORE16
#define ATTN_STORE16(p,v) (*(u32x4*)(p)=(v))
#endif
template<int THRL> __device__ __forceinline__ void attn_unit(const bf16*Qu,const bf16*__restrict__ Kh,const bf16*__restrict__ Vh,const int NT,bf16*Ou,const bf16*Gu,char*shm){
  int tid_=threadIdx.x; asm volatile("":"+v"(tid_)); const int tid=tid_,lane=tid&63,r32=lane&31,hi=lane>>5; const int wid=__builtin_amdgcn_readfirstlane(tid>>6);
  const bf16*Qw=Qu+(long)(wid*QBLK)*QP;
  const unsigned lds0=(unsigned)(uintptr_t)shm;
  float*wsf=(float*)(shm+LDS_WS)+wid*64;
  const bf16*ksrc=Kh+(long)lane*KVP+wid*8;
  const bf16*vsrc=Vh+(long)(16*(wid&3)+(lane>>2))*KVP+(wid>>2)*32+(lane&3)*8;
  const unsigned kdst=lds0+LDS_K+wid*1024, vdst=lds0+LDS_V+wid*1024;
  #define DMA_K(t,slot) glds16(ksrc+(long)(t)*KVBLK*KVP,(unsigned)__builtin_amdgcn_readfirstlane(kdst+(slot)))
  #define DMA_V(t,slot) glds16(vsrc+(long)(t)*KVBLK*KVP,(unsigned)__builtin_amdgcn_readfirstlane(vdst+(slot)))
  const int vb0=(int)(lds0+LDS_V)+((lane>>4)&1)*32+(lane&3)*8+(4*hi+((lane&15)>>2))*64;
  const char*Kbase=shm+LDS_K; bf16x8 kf[8];
  const lds_cptr shm3=(lds_cptr)shm; const lds_cptr kp0=shm3+LDS_K+hi*1024+r32*16; const lds_cptr vp0=shm3+LDS_V+((lane>>4)&1)*32+(lane&3)*8+(4*hi+((lane&15)>>2))*64;
  DMA_K(0,0);DMA_V(0,0);DMA_K(1,SLOTB);
  bf16x8 qr[4];
  #pragma unroll
  for(int d0=0;d0<4;++d0)qr[d0]=*reinterpret_cast<const bf16x8*>(&Qw[(long)r32*QP+d0*16+hi*8]);
  float mhat=0.f,l_reg=0.f;f32x16 o[2];o[0]=f32x16{};o[1]=f32x16{};f32x16 negm=f32x16{};asm volatile("":"+v"(negm));
  #define CMASK(P0,P1,t) do{}while(0)
  bool resc=false;
  #define START(P0,P1) do{ const float rm=rowmax(P0,P1); resc=false; \
    { const float dl=rm; mhat=fadd_s(mhat,dl); \
      _Pragma("unroll") for(int r=0;r<16;++r){P0[r]=fsub_s(P0[r],dl);P1[r]=fsub_s(P1[r],dl);} \
      _Pragma("unroll") for(int r=0;r<16;++r)negm[r]=-mhat; asm volatile("":"+v"(negm)); } \
    _Pragma("unroll") for(int r=0;r<16;++r)P0[r]=__builtin_amdgcn_exp2f(P0[r]); }while(0)
  #define RESC() do{ if(resc){ asm volatile("s_waitcnt lgkmcnt(0)":::"memory"); \
      _Pragma("unroll") for(int d_=0;d_<2;++d_) _Pragma("unroll") for(int r=0;r<16;++r)o[d_][r]*=wsf[crow(r,hi)]; } }while(0)
  f32x16 pA0,pA1,pB0,pB1;
  int sl_prev=0,sl_cur=0,sl_next=SLOTB;
  #define ROT() do{sl_prev=sl_cur;sl_cur=sl_next;sl_next=(sl_next==(NSLOT-1)*SLOTB)?0:sl_next+SLOTB;}while(0)
  DMA_K(2,2*SLOTB);
  WAIT_BAR(3);
  qkt(pA0,pA1,Kbase,qr,negm,r32,hi);asm volatile("s_nop 15\n\ts_nop 7":"+v"(pA0),"+v"(pA1));CMASK(pA0,pA1,0);
  START(pA0,pA1);
  _Pragma("unroll") for(int r=0;r<16;++r)pA1[r]=__builtin_amdgcn_exp2f(pA1[r]);
  WAIT_BAR(0);
  DMA_K(3,0);DMA_V(1,SLOTB);
  ROT();
  kload8(kf,kp0+sl_cur);
  WAIT_BAR(2);
  s16x4 vlo[8],vhi[8]; u32x4 pw0,pw1,pw2,pw3;
  #define PKW(P,B) cvtpk_s(P[B],P[B+1])
  #define PAF(k) __builtin_bit_cast(bf16x8,pw##k)
  #define VFR(i) (bf16x8){vlo[i][0],vlo[i][1],vlo[i][2],vlo[i][3],vhi[i][0],vhi[i][1],vhi[i][2],vhi[i][3]}
  #define PIN(x) asm volatile("":"+v"(x))
  #define MX3(a,b,c) __builtin_fmaxf(__builtin_fmaxf((a),(b)),(c))
  #define GAPA(MF,A0,A1,A2,A3,W0,W1,PW) do{ MF; sacc+=A0; sacc+=A1; sacc+=A2; sacc+=A3; PIN(sacc); W0; W1; PIN(PW); SBAR(); }while(0)
  #define EX(v) __builtin_amdgcn_exp2f(v)
  #define GAPB(MF,X,B) do{ MF; X[B]=EX(X[B]); X[B+1]=EX(X[B+1]); X[B+2]=EX(X[B+2]); X[B+3]=EX(X[B+3]); PIN(X); SBAR(); }while(0)
  #define VRD(i) do{ vlo[i]=vtr(vp_+(((i)>>2)*4096+((i)&3)*1024)); vhi[i]=vtr(vp_+(((i)>>2)*4096+((i)&3)*1024+512)); }while(0)
  #define KRD(G,j) do{ if(G){ kload2(kf,kp0+sl_next,j); SBAR(); } }while(0)
  #define STEP(C0,C1,P0,P1,t,GK,GV,GL) do{ SBAR(); \
    const lds_cptr vp_=vp0+sl_prev; \
    VRD(0); SBAR(); float sacc=(P0[0]+P0[1]); \
    GAPA(C0=__builtin_amdgcn_mfma_f32_32x32x16_bf16(kf[0],qr[0],negm,0,0,0), P0[2],P0[3],P0[4],P0[5],     pw0[0]=PKW(P0,0), pw0[1]=PKW(P0,2), pw0); \
    VRD(4); SBAR(); GAPA(C1=__builtin_amdgcn_mfma_f32_32x32x16_bf16(kf[1],qr[0],negm,0,0,0), P0[6],P0[7],P0[8],P0[9],     pw0[2]=PKW(P0,4), pw0[3]=PKW(P0,6), pw0); \
    VRD(1); SBAR(); GAPA(C0=__builtin_amdgcn_mfma_f32_32x32x16_bf16(kf[2],qr[1],C0,0,0,0),   P0[10],P0[11],P0[12],P0[13], pw1[0]=PKW(P0,8), pw1[1]=PKW(P0,10), pw1); \
    VRD(5); SBAR(); GAPA(C1=__builtin_amdgcn_mfma_f32_32x32x16_bf16(kf[3],qr[1],C1,0,0,0),   P0[14],P0[15],P1[0],P1[1],   pw1[2]=PKW(P0,12),pw1[3]=PKW(P0,14), pw1); \
    VRD(2); SBAR(); GAPA(C0=__builtin_amdgcn_mfma_f32_32x32x16_bf16(kf[4],qr[2],C0,0,0,0),   P1[2],P1[3],P1[4],P1[5],     pw2[0]=PKW(P1,0), pw2[1]=PKW(P1,2), pw2); \
    VRD(6); SBAR(); GAPA(C1=__builtin_amdgcn_mfma_f32_32x32x16_bf16(kf[5],qr[2],C1,0,0,0),   P1[6],P1[7],P1[8],P1[9],     pw2[2]=PKW(P1,4), pw2[3]=PKW(P1,6), pw2); \
    VRD(3); SBAR(); GAPA(C0=__builtin_amdgcn_mfma_f32_32x32x16_bf16(kf[6],qr[3],C0,0,0,0),   P1[10],P1[11],P1[12],P1[13], pw3[0]=PKW(P1,8), pw3[1]=PKW(P1,10), pw3); \
    VRD(7); SBAR(); GAPA(C1=__builtin_amdgcn_mfma_f32_32x32x16_bf16(kf[7],qr[3],C1,0,0,0),   P1[14],P1[15],0.f,0.f,       pw3[2]=PKW(P1,12),pw3[3]=PKW(P1,14), pw3); \
    l_reg+=sacc; \
    if(GK){DMA_K((t)+3,sl_cur);} if(GV){DMA_V((t)+1,sl_next);} \
    CMASK(C0,C1,t); \
    { float a=MX3(C0[0],C0[1],C1[0]),b=MX3(C0[2],C0[3],C1[1]); a=MX3(a,C1[2],C1[3]); \
      _Pragma("unroll") for(int r=4;r<16;r+=4){a=MX3(a,C0[r],C0[r+1]);b=MX3(b,C0[r+2],C0[r+3]);a=MX3(a,C1[r],C1[r+1]);b=MX3(b,C1[r+2],C1[r+3]);} \
      float rm=__builtin_fmaxf(a,b); { auto rr=__builtin_amdgcn_permlane32_swap(__float_as_uint(rm),__float_as_uint(rm),false,false); rm=__builtin_fmaxf(__uint_as_float(rr[0]),__uint_as_float(rr[1])); } \
      resc=false; \
      if(__builtin_expect(__any(rm>(float)THRL),0)){ const float dl=__builtin_fmaxf(rm,0.f); mhat+=dl; \
        _Pragma("unroll") for(int r=0;r<16;++r){C0[r]-=dl;C1[r]-=dl;} \
        _Pragma("unroll") for(int r=0;r<16;++r)negm[r]=-mhat; asm volatile("":"+v"(negm)); \
        const float f=__builtin_amdgcn_exp2f(-dl); l_reg*=f; if(hi==0)wsf[r32]=f; resc=true; } } \
    SBAR(); \
    GAPB(o[0]=__builtin_amdgcn_mfma_f32_32x32x16_bf16(PAF(0),VFR(0),o[0],0,0,0), C0,0); \
    GAPB(o[1]=__builtin_amdgcn_mfma_f32_32x32x16_bf16(PAF(0),VFR(4),o[1],0,0,0), C0,4); \
    KRD(GL,0); GAPB(o[0]=__builtin_amdgcn_mfma_f32_32x32x16_bf16(PAF(1),VFR(1),o[0],0,0,0), C0,8); \
    KRD(GL,1); GAPB(o[1]=__builtin_amdgcn_mfma_f32_32x32x16_bf16(PAF(1),VFR(5),o[1],0,0,0), C0,12); \
    KRD(GL,2); GAPB(o[0]=__builtin_amdgcn_mfma_f32_32x32x16_bf16(PAF(2),VFR(2),o[0],0,0,0), C1,0); \
    KRD(GL,3); GAPB(o[1]=__builtin_amdgcn_mfma_f32_32x32x16_bf16(PAF(2),VFR(6),o[1],0,0,0), C1,4); \
    GAPB(o[0]=__builtin_amdgcn_mfma_f32_32x32x16_bf16(PAF(3),VFR(3),o[0],0,0,0), C1,8); \
    GAPB(o[1]=__builtin_amdgcn_mfma_f32_32x32x16_bf16(PAF(3),VFR(7),o[1],0,0,0), C1,12); \
    }while(0)
  int t=1;
  #undef CMASK
  #define CMASK(P0,P1,t) do{}while(0)
  for(;t+5<NT;t+=2){
    STEP(pB0,pB1,pA0,pA1,t,true,true,true);     WAIT_BAR(2); RESC(); ROT();
    STEP(pA0,pA1,pB0,pB1,t+1,true,true,true);   WAIT_BAR(2); RESC(); ROT();
  }
  #undef CMASK
  #define CMASK(P0,P1,t) do{}while(0)
  #define ENDW(tt) do{ if((tt)+3<NT){WAIT_BAR(2);} else if((tt)+2<NT){WAIT_BAR(1);} else {WAIT_BAR(0);} }while(0)
  for(;t+1<NT;t+=2){
    STEP(pB0,pB1,pA0,pA1,t,(t+3<NT),(t+1<NT),(t+1<NT));       ENDW(t);   RESC(); ROT();
    STEP(pA0,pA1,pB0,pB1,t+1,(t+4<NT),(t+2<NT),(t+2<NT));     ENDW(t+1); RESC(); ROT();
  }
  STEP(pB0,pB1,pA0,pA1,NT-1,false,false,false); RESC();
  { float sacc=pB0[0]+pB0[1]; _Pragma("unroll") for(int r=2;r<16;++r)sacc+=pB0[r]; _Pragma("unroll") for(int r=0;r<16;++r)sacc+=pB1[r]; l_reg+=sacc;
    pw0=(u32x4){PKW(pB0,0),PKW(pB0,2),PKW(pB0,4),PKW(pB0,6)};pw1=(u32x4){PKW(pB0,8),PKW(pB0,10),PKW(pB0,12),PKW(pB0,14)};pw2=(u32x4){PKW(pB1,0),PKW(pB1,2),PKW(pB1,4),PKW(pB1,6)};pw3=(u32x4){PKW(pB1,8),PKW(pB1,10),PKW(pB1,12),PKW(pB1,14)};
    SBAR(); pv(o,vb0+sl_cur,PAF(0),PAF(1),PAF(2),PAF(3)); }
  #undef PKW
  #undef PAF
  #undef VFR
  #undef PIN
  #undef MX3
  #undef GAPA
  #undef GAPB
  #undef EX
  #undef VRD
  #undef KRD
  #undef STEP
  #undef ENDW
  {auto rr=__builtin_amdgcn_permlane32_swap(__float_as_uint(l_reg),__float_as_uint(l_reg),false,false);l_reg=__uint_as_float(rr[0])+__uint_as_float(rr[1]);}
  if(hi==0)wsf[32+r32]=l_reg;asm volatile("s_waitcnt lgkmcnt(0)":::"memory");
  float rli[16];
  #pragma unroll
  for(int r=0;r<16;++r)rli[r]=__builtin_amdgcn_rcpf(wsf[32+crow(r,hi)]);
  bf16*Ow=Ou+(long)(wid*QBLK)*QP; const bf16*Gw=Gu+(long)(wid*QBLK)*QP;
  { bf16*stg=(bf16*)(shm+LDS_OST)+wid*2048;
    #pragma unroll
    for(int r=0;r<16;++r){const int orow=crow(r,hi);
      #pragma unroll
      for(int d0=0;d0<2;++d0)stg[orow*64+d0*32+r32]=__float2bfloat16(o[d0][r]*rli[r]);}
    asm volatile("s_waitcnt lgkmcnt(0)":::"memory");
    #pragma unroll
    for(int i=0;i<4;++i){const int row=i*8+(lane>>3),ch=lane&7; const u32x4 v=*(const u32x4*)(stg+row*64+ch*8); const u32x4 gg=*(const u32x4*)(Gw+(long)row*QP+ch*8); u32x4 w_;
      _Pragma("unroll") for(int e_=0;e_<4;++e_){ const float a0=__uint_as_float(v[e_]<<16)*__uint_as_float(gg[e_]<<16), a1=__uint_as_float(v[e_]&0xffff0000u)*__uint_as_float(gg[e_]&0xffff0000u); w_[e_]=cvtpk_s(a0,a1); }
      ATTN_STORE16(Ow+(long)row*QP+ch*8,w_);} }
  asm volatile("s_waitcnt lgkmcnt(0)\n\ts_barrier":::"memory");
  #undef DMA_K
  #undef DMA_V
  #undef CMASK
  #undef START
  #undef RESC
  #undef ROT
}
constexpr int ATTN_LDS_BYTES=LDS_BYTES;
#undef SBAR
#undef WAIT_BAR
}
constexpr int NWAVES = 8;
constexpr int N_LAUNCHES = MK_N_LAUNCHES;
constexpr int NPHASE = 10;
constexpr int DM = 1024, MTOK = 12288, MP = 8192, NB_P = 32, L_P = 256, NB_S = 4, L_S = 1024, PAST = 256;
constexpr int N1 = 2560, N3 = 5120, KVROWS = MP + NB_S * (PAST + L_S);
constexpr float LN_EPS = 1e-5f;
constexpr size_t OUT_Y = 0, OUT_K = (size_t)MTOK * DM, OUT_V = OUT_K + (size_t)MP * 256, OUT_S = OUT_V + (size_t)MP * 256, OUT_END = OUT_S + (size_t)NB_P * 2 * 8 * 128 * 128;
constexpr size_t MiB = 1u << 20;
constexpr size_t WS_CTL = 0, CTL_ZERO_BYTES = 1 * MiB;
constexpr size_t WS_MOD = 512 * 1024;
constexpr size_t WS_ROPE = 1 * MiB;
constexpr size_t WS_W1 = 2 * MiB, WS_W2 = 7 * MiB, WS_W3 = 9 * MiB, WS_W4 = 19 * MiB;
constexpr size_t WS_A = 22 * MiB;
constexpr size_t WS_B = 46 * MiB;
constexpr size_t WS_C = 70 * MiB;
constexpr size_t WS_D = 94 * MiB;
constexpr size_t WS_KALL = 118 * MiB, WS_VALL = 125 * MiB;
constexpr size_t WS_LF = 132 * MiB;
constexpr size_t WS_KR = 180 * MiB;
constexpr size_t WS_OF = 228 * MiB;
constexpr size_t WS_END = 252 * MiB;
static_assert((size_t)KVROWS * 256 * 2 <= 7 * MiB && (size_t)MTOK * DM * 2 == 24 * MiB, "ws map");
constexpr int CW_BAR = 4096, CW_GLA = 16384;

constexpr int RING_OFF = 0, RING_BYTES = 131072;
constexpr int LDSCTL_OFF = RING_BYTES, MISC_OFF = LDSCTL_OFF + 320;
constexpr int LDS_BYTES = 147456;
#define GAS __attribute__((address_space(1)))
#define LAS __attribute__((address_space(3)))
typedef unsigned short bf16;
typedef unsigned v4u __attribute__((ext_vector_type(4)));
typedef float f32x4 __attribute__((ext_vector_type(4)));
typedef short bf16x8 __attribute__((ext_vector_type(8)));
typedef GAS unsigned gu32;
typedef GAS unsigned long long gu64;
#define RLX_AGENT __ATOMIC_RELAXED, __HIP_MEMORY_SCOPE_AGENT
#define LDS_WAIT() asm volatile("s_waitcnt lgkmcnt(0)" ::: "memory")
#define VM_WAIT() asm volatile("s_waitcnt vmcnt(0)" ::: "memory")
__device__ __forceinline__ unsigned long long rt() { return __builtin_amdgcn_s_memrealtime(); }
__device__ __forceinline__ unsigned f2bf(float f) { unsigned u = __builtin_bit_cast(unsigned, f); return (u + 0x7fffu + ((u >> 16) & 1u)) >> 16; }
__device__ __forceinline__ unsigned pk2(float lo, float hi) { return f2bf(lo) | (f2bf(hi) << 16); }

#define XB_TMO      128
#define XB_XCNT(j)  (256  + 64 * (j))
#define XB_XSUB(j)  (1280 + 64 * (j))
#define XB_XGEN(j)  (2304 + 64 * (j))
#define XB_TOP      3328
#define XB_TOPGEN   3392
#define XCD_BAR_WORDS 3456
#define XB_SPIN_CAP (1u << 18)

__device__ __forceinline__ unsigned xb_ld(unsigned* p)              { return __hip_atomic_load(p, __ATOMIC_RELAXED, __HIP_MEMORY_SCOPE_AGENT); }
__device__ __forceinline__ unsigned xb_add(unsigned* p, unsigned v) { return __hip_atomic_fetch_add(p, v, __ATOMIC_RELAXED, __HIP_MEMORY_SCOPE_AGENT); }
__device__ __forceinline__ unsigned xb_xcc_id() { return (unsigned)__builtin_amdgcn_s_getreg((3 << 11) | 20) & 0xFu; }
#define XB_SPIN(cond, bar) do { unsigned _sp = 0; while (cond) { __builtin_amdgcn_s_sleep(1); \
    if ((++_sp & 255u) == 0u) { if (xb_ld(&(bar)[XB_TMO])) break; if (_sp > XB_SPIN_CAP) { atomicAdd(&(bar)[XB_TMO], 1u); break; } } } } while (0)

struct XcdBarrier {
    unsigned* bar; unsigned x;
    volatile LAS unsigned* st;
};

__device__ __forceinline__ XcdBarrier xcd_barrier_post(unsigned* bar, volatile LAS unsigned* st) {
    XcdBarrier b; b.bar = bar; b.x = xb_xcc_id(); b.st = st;
    if (threadIdx.x == 0) (void)xb_add(&bar[XB_XCNT(b.x)], 1u);
    return b;
}
__device__ __forceinline__ void xcd_barrier_complete(unsigned* bar, unsigned x, unsigned& nloc, unsigned& nx) {
    const unsigned G = gridDim.x * gridDim.y * gridDim.z;
    unsigned sum, cnt, mine, sp = 0u;
    for (;;) {
        sum = 0u; cnt = 0u; mine = 0u;
#pragma unroll
        for (unsigned j = 0; j < 16; ++j) { const unsigned c = xb_ld(&bar[XB_XCNT(j)]); sum += c; cnt += (c > 0u) ? 1u : 0u; mine = (j == x) ? c : mine; }
        if (sum == G) break;
        __builtin_amdgcn_s_sleep(1);
        if ((++sp & 255u) == 0u) { if (xb_ld(&bar[XB_TMO])) break; if (sp > XB_SPIN_CAP) { atomicAdd(&bar[XB_TMO], 1u); break; } }
    }
    nloc = mine > 0u ? mine : 1u; nx = cnt > 0u ? cnt : 1u;
}

__device__ __forceinline__ void xcd_barrier(const XcdBarrier& b) {
    asm volatile("s_waitcnt vmcnt(0)" ::: "memory");
    __syncthreads();
    if (threadIdx.x == 0) {
        unsigned* bar = b.bar;
        __builtin_amdgcn_s_waitcnt(0);
        unsigned nloc = b.st[0], nx = b.st[1];
        if (nloc == 0u) { xcd_barrier_complete(bar, b.x, nloc, nx); b.st[0] = nloc; b.st[1] = nx; }
        const unsigned old = xb_add(&bar[XB_XSUB(b.x)], 1u);
        const unsigned gen = old / nloc;
        if (old + 1u == (gen + 1u) * nloc) {
            __builtin_amdgcn_fence(__ATOMIC_RELEASE, "agent");
            asm volatile("s_waitcnt vmcnt(0)" ::: "memory");
            const unsigned og = xb_add(&bar[XB_TOP], 1u);
            const unsigned tg = og / nx;
            if (og + 1u == (tg + 1u) * nx) xb_add(&bar[XB_TOPGEN], 1u);
            else XB_SPIN(xb_ld(&bar[XB_TOPGEN]) == tg, bar);
            __builtin_amdgcn_fence(__ATOMIC_ACQUIRE, "agent");
            xb_add(&bar[XB_XGEN(b.x)], 1u);
            asm volatile("s_waitcnt vmcnt(0)" ::: "memory");
        } else {
            XB_SPIN(xb_ld(&bar[XB_XGEN(b.x)]) == gen, bar);
            __builtin_amdgcn_fence(__ATOMIC_ACQUIRE, "agent");
            asm volatile("s_waitcnt vmcnt(0)" ::: "memory");
        }
    }
    __syncthreads();
}
struct Frame {
    LAS unsigned char* lds;
    volatile LAS unsigned* MISC;
    gu32* ctl;
    int tid, lane, wave, vcu, G;
};
__device__ __forceinline__ float bf2f_lo(unsigned u) { return __uint_as_float(u << 16); }
__device__ __forceinline__ float bf2f_hi(unsigned u) { return __uint_as_float(u & 0xffff0000u); }
__device__ __forceinline__ float wave_sum(float v) {
#pragma unroll
    for (int o = 1; o < 64; o <<= 1) v += __shfl_xor(v, o);
    return v;
}
__device__ __forceinline__ void sincos_cw(float x, float& sn, float& cs) {
    const float kf = rintf(x * 0.63661977236758134f); const int k = (int)kf;
    float r = fmaf(-kf, 1.5707962513e+00f, x); r = fmaf(-kf, 7.5497894159e-08f, r);
    const float r2 = r * r;
    const float s = r + r * r2 * (-1.6666666667e-01f + r2 * (8.3333333333e-03f + r2 * (-1.9841269841e-04f + r2 * 2.7557319224e-06f)));
    const float c = 1.0f + r2 * (-0.5f + r2 * (4.1666666667e-02f + r2 * (-1.3888888889e-03f + r2 * (2.4801587302e-05f + r2 * -2.7557319224e-07f))));
    switch (k & 3) { case 0: sn = s; cs = c; break; case 1: sn = c; cs = -s; break; case 2: sn = -s; cs = -c; break; default: sn = -c; cs = s; break; }
}
__device__ __forceinline__ int slot_of(int mode, int n) {
    if (mode == 0) return n;
    const int t = n & ~255, L = n & 255;
    if (mode == 1 && (n >> 8) <= 4) { const int wc = L >> 6, bj = (L >> 5) & 1; return t + 128 * bj + 32 * wc + (L & 31); }
    const int hi = L & ~31, r5 = L & 31, fq = r5 >> 3, nn = (r5 >> 2) & 1, e = r5 & 3; return t + hi + 16 * nn + 4 * fq + e;
}
__device__ __forceinline__ void p0_transpose_item(const float* W, int K, int N, bf16* WT, int mode, LAS float* scr, int item, int lane) {
    const int nblk = N / 32, kb = item / nblk, nb = item % nblk, k0 = 64 * kb, n0 = 32 * nb;
#pragma unroll 8
    for (int i = 0; i < 32; ++i) { const int kk = 2 * i + (lane >> 5); scr[kk * 33 + (lane & 31)] = W[(size_t)(k0 + kk) * N + n0 + (lane & 31)]; }
    LDS_WAIT(); asm volatile("" ::: "memory");
    const int c = lane & 7;
#pragma unroll
    for (int j = 0; j < 4; ++j) { const int n = (lane >> 3) + 8 * j; const LAS float* s = scr + (8 * c) * 33 + n;
        v4u o; o.x = pk2(s[0 * 33], s[1 * 33]); o.y = pk2(s[2 * 33], s[3 * 33]); o.z = pk2(s[4 * 33], s[5 * 33]); o.w = pk2(s[6 * 33], s[7 * 33]);
        *(GAS v4u*)(WT + (size_t)slot_of(mode, n0 + n) * K + k0 + 8 * c) = o; }
    LDS_WAIT(); asm volatile("" ::: "memory");
}
struct Ptrs {
    const float *x_prompt, *x_sample, *cache_k, *cache_v, *state_rec, *c, *c_ctx, *ada_w, *ada_b, *attn_w_in, *attn_q_gain, *attn_k_gain, *attn_w_out,
                *rec_w_in, *rec_lb, *rec_norm_gain, *rec_w_out, *ln_gain, *ln_bias;
    float* out; unsigned char* ws;
};
__device__ __forceinline__ void p0_adaln_item(const Ptrs& P, float* mod, LAS float* scr, int item, int lane) {
    const int kc = item & 7, cbk = (item >> 3) % 48, l = item / (8 * 48), k0 = kc * 128, c0 = cbk * 64;
#pragma unroll
    for (int j = 0; j < 5; ++j)
#pragma unroll
        for (int t = 0; t < 2; ++t) { const int kk = lane + 64 * t; const float cv = (j == 0) ? P.c_ctx[k0 + kk] : P.c[(j - 1) * 1024 + k0 + kk]; scr[j * 128 + kk] = cv / (1.f + __expf(-cv)); }
    LDS_WAIT(); asm volatile("" ::: "memory");
    float a0 = 0.f, a1 = 0.f, a2 = 0.f, a3 = 0.f, a4 = 0.f;
    const float* w = P.ada_w + (size_t)l * 1024 * 3072 + (size_t)k0 * 3072 + c0 + lane;
#pragma unroll 8
    for (int kk = 0; kk < 128; ++kk) { const float wv = w[(size_t)kk * 3072];
        a0 += scr[kk] * wv; a1 += scr[128 + kk] * wv; a2 += scr[256 + kk] * wv; a3 += scr[384 + kk] * wv; a4 += scr[512 + kk] * wv; }
    if (kc == 0) { const float b = P.ada_b[l * 3072 + c0 + lane]; a0 += b; a1 += b; a2 += b; a3 += b; a4 += b; }
    float* mo = mod + (size_t)l * 5 * 3072 + c0 + lane;
    atomicAdd(mo, a0); atomicAdd(mo + 3072, a1); atomicAdd(mo + 2 * 3072, a2); atomicAdd(mo + 3 * 3072, a3); atomicAdd(mo + 4 * 3072, a4);
    LDS_WAIT(); asm volatile("" ::: "memory");
}
__device__ __forceinline__ void p0_prologue(Frame& F, const Ptrs& P, const bool with_adaln) {
    int lane_ = threadIdx.x & 63; asm volatile("" : "+v"(lane_));
    LAS float* scr = (LAS float*)(F.lds + RING_OFF + F.wave * 16384);
    const int gw = F.vcu * NWAVES + F.wave, NGW = F.G * NWAVES;
    bf16* W1 = (bf16*)(P.ws + WS_W1); bf16* W2 = (bf16*)(P.ws + WS_W2); bf16* W3 = (bf16*)(P.ws + WS_W3); bf16* W4 = (bf16*)(P.ws + WS_W4);
    constexpr int I_1 = (DM / 64) * (N1 / 32), I_2 = (DM / 64) * (DM / 32), I_3 = (DM / 64) * (N3 / 32), I_4 = I_2, I_A = 2 * 48 * 8;
    constexpr int NITEMS = I_A + I_1 + I_2 + I_3 + I_4;
    for (int it = gw; it < NITEMS; it += NGW) {
        int r = it;
        if (r < I_A) { if (with_adaln) p0_adaln_item(P, (float*)(P.ws + WS_MOD), scr, r, lane_); continue; } r -= I_A;
        if (r < I_1) { p0_transpose_item(P.attn_w_in, DM, N1, W1, 1, scr, r, lane_); continue; } r -= I_1;
        if (r < I_2) { p0_transpose_item(P.attn_w_out, DM, DM, W2, 0, scr, r, lane_); continue; } r -= I_2;
        if (r < I_3) { p0_transpose_item(P.rec_w_in, DM, N3, W3, 2, scr, r, lane_); continue; } r -= I_3;
        p0_transpose_item(P.rec_w_out, DM, DM, W4, 0, scr, r, lane_);
    }
    const int gt = gw * 64 + lane_, NGT = NGW * 64;
    if (gt < 1024) { const int pos = gt >> 4, i = gt & 15; const float inv = exp2f(-(float)i * (13.287712379549449f / 16.0f)); const float ang = (float)pos * inv;
        float* tab = (float*)(P.ws + WS_ROPE); float sn, cs; sincos_cw(ang, sn, cs); tab[pos * 32 + i] = cs; tab[pos * 32 + 16 + i] = sn; }
    bf16* Kall = (bf16*)(P.ws + WS_KALL); bf16* Vall = (bf16*)(P.ws + WS_VALL);
    for (int it = gt; it < 2 * 32768; it += NGT) { const int which = it >> 15, i8 = it & 32767, b = i8 >> 13, t = (i8 >> 5) & 255, c8 = i8 & 31;
        const float* src = (which ? P.cache_v : P.cache_k) + ((size_t)(b * 256 + t) * 256 + c8 * 8);
        const f32x4 x0 = *(const GAS f32x4*)src, x1 = *(const GAS f32x4*)(src + 4);
        v4u o; o.x = pk2(x0.x, x0.y); o.y = pk2(x0.z, x0.w); o.z = pk2(x1.x, x1.y); o.w = pk2(x1.z, x1.w);
        *(GAS v4u*)((which ? Vall : Kall) + ((size_t)(MP + b * 1280 + t) * 256 + c8 * 8)) = o; }
}
__device__ __forceinline__ void p1_modulate(Frame& F, const Ptrs& P) {
    int lane_ = threadIdx.x & 63; asm volatile("" : "+v"(lane_));
    const int gw = F.vcu * NWAVES + F.wave, NGW = F.G * NWAVES;
    const float* mod = (const float*)(P.ws + WS_MOD); bf16* H = (bf16*)(P.ws + WS_A);
    for (int m = gw; m < MTOK; m += NGW) {
        const int cond = m < MP ? 0 : 1 + ((m - MP) >> 10);
        const float* xr = m < MP ? P.x_prompt + (size_t)m * DM : P.x_sample + (size_t)(m - MP) * DM;
        const float* sh = mod + (size_t)cond * 3072, *sc = sh + 1024;
        GAS unsigned long long* o8 = (GAS unsigned long long*)(H + (size_t)m * DM) + lane_;
#pragma unroll
        for (int j = 0; j < 4; ++j) { const int c = 4 * lane_ + 256 * j; const f32x4 x = *(const GAS f32x4*)(xr + c), s = *(const GAS f32x4*)(sc + c), t = *(const GAS f32x4*)(sh + c);
            const f32x4 h = x * (s + 1.0f) + t; o8[64 * j] = (unsigned long long)pk2(h.x, h.y) | ((unsigned long long)pk2(h.z, h.w) << 32); }
    }
}
template <bool WITH_H>
__device__ __forceinline__ void p_layernorm(Frame& F, const Ptrs& P, float* Y, const float* lng, const float* lnb, const float* modl) {
    int lane_ = threadIdx.x & 63; asm volatile("" : "+v"(lane_));
    const int gw = F.vcu * NWAVES + F.wave, NGW = F.G * NWAVES; bf16* H = (bf16*)(P.ws + WS_A);
    for (int m = gw; m < MTOK; m += NGW) {
        GAS f32x4* yr = (GAS f32x4*)(Y + (size_t)m * DM) + lane_;
        f32x4 v[4]; float s = 0.f;
#pragma unroll
        for (int j = 0; j < 4; ++j) { v[j] = yr[64 * j]; s += (v[j].x + v[j].y) + (v[j].z + v[j].w); }
        const float mean = wave_sum(s) * (1.f / DM); float s2 = 0.f;
#pragma unroll
        for (int j = 0; j < 4; ++j) { v[j] = v[j] - mean; s2 += (v[j].x * v[j].x + v[j].y * v[j].y) + (v[j].z * v[j].z + v[j].w * v[j].w); }
        const float rstd = rsqrtf(wave_sum(s2) * (1.f / DM) + LN_EPS);
        const int cond = m < MP ? 0 : 1 + ((m - MP) >> 10);
        GAS unsigned long long* o8 = (GAS unsigned long long*)(H + (size_t)m * DM) + lane_;
#pragma unroll
        for (int j = 0; j < 4; ++j) { const int c = 4 * lane_ + 256 * j; const f32x4 g = *(const GAS f32x4*)(lng + c), b = *(const GAS f32x4*)(lnb + c);
            const f32x4 x1 = v[j] * rstd * g + b; yr[64 * j] = x1;
            if (WITH_H) { const f32x4 t = *(const GAS f32x4*)(modl + (size_t)cond * 3072 + c), sc = *(const GAS f32x4*)(modl + (size_t)cond * 3072 + 1024 + c);
                const f32x4 h = x1 * (sc + 1.0f) + t; o8[64 * j] = (unsigned long long)pk2(h.x, h.y) | ((unsigned long long)pk2(h.z, h.w) << 32); } }
    }
}
namespace gla {
typedef short bf16x8 __attribute__((ext_vector_type(8)));
typedef float f32x4 __attribute__((ext_vector_type(4)));
typedef float f32x2 __attribute__((ext_vector_type(2)));
typedef unsigned u32x2 __attribute__((ext_vector_type(2)));
typedef unsigned u32x4 __attribute__((ext_vector_type(4)));
typedef _Float16 f16x2 __attribute__((ext_vector_type(2)));
#define GLAS __attribute__((address_space(3)))
constexpr int QT_OFF = 0, QT_STR = 272, KT_OFF = 17408, KH_OFF = 34816, KH_STR = 144, VT_OFF = KH_OFF + 128 * KH_STR, AS_OFF = VT_OFF + 128 * KH_STR, AS_STR = 144,
              TOT_OFF = AS_OFF + 64 * AS_STR, EBR_OFF = TOT_OFF + 4096, EBL_OFF = EBR_OFF + 512, RS_OFF = EBL_OFF + 512, GLA_LDS_BYTES = RS_OFF + 2048;
static_assert(KT_OFF == 64 * QT_STR && KH_OFF == 2 * 64 * QT_STR && GLA_LDS_BYTES <= 131072, "gla lds map");
struct GlaT { const unsigned short *QR, *KR, *VR, *GR; const _Float16* LF; unsigned short *OF, *GO; const float* ngain; };
__device__ __forceinline__ unsigned pkbf(float lo, float hi) { typedef float f2 __attribute__((ext_vector_type(2))); typedef __bf16 b2 __attribute__((ext_vector_type(2))); f2 v = {lo, hi}; b2 b = __builtin_convertvector(v, b2); return __builtin_bit_cast(unsigned, b); }
__device__ __forceinline__ float lo2f(unsigned u) { return __uint_as_float(u << 16); }
__device__ __forceinline__ float hi2f(unsigned u) { return __uint_as_float(u & 0xffff0000u); }
template <int MODE>
__device__ __forceinline__ void scan(GLAS unsigned char* lds, const GlaT& T, const int rowbase, const int nch, const int h, const int dir, const float* s0, float* sout, unsigned* myflag, unsigned* peerflag) {
    int tid_ = threadIdx.x; asm volatile("" : "+v"(tid_)); const int tid = tid_, lane = tid & 63, w = __builtin_amdgcn_readfirstlane(tid >> 6), g = lane >> 4, c = lane & 15;
    f32x4 S[8];
#pragma unroll
    for (int t = 0; t < 8; ++t) {
        if (s0) {
#pragma unroll
            for (int r = 0; r < 4; ++r) S[t][r] = s0[(size_t)(16 * t + 4 * g + r) * 128 + 16 * w + c];
        } else S[t] = (f32x4){0.f, 0.f, 0.f, 0.f};
    }
    const f32x4 ng = *(const f32x4*)(T.ngain + 16 * w + 4 * g);
    const size_t colq = (size_t)h * 128 + 2 * lane;
    const unsigned short* KRd = T.KR + (size_t)dir * MTOK * 1024; const _Float16* LFd = T.LF + (size_t)dir * MTOK * 1024;
    const int dk0 = 2 * lane, pos0 = (dk0 & ~31) + 8 * ((dk0 >> 2) & 3) + 4 * ((dk0 >> 4) & 1) + (dk0 & 3);
    f16x2 lfv[8]; unsigned qv[8], kv[8], vv[8];
#define GLA_LOAD(ci) do { const int r0n_ = rowbase + 64 * (dir ? (nch - 1 - (ci)) : (ci)); _Pragma("unroll") for (int ii = 0; ii < 8; ++ii) { const int p = 8 * w + ii; const size_t ro = (size_t)(r0n_ + (dir ? 63 - p : p)) * 1024 + colq; \
        lfv[ii] = *(const f16x2*)(LFd + ro); qv[ii] = *(const unsigned*)(T.QR + ro); kv[ii] = *(const unsigned*)(KRd + ro); vv[ii] = *(const unsigned*)(T.VR + ro); } } while (0)
    GLA_LOAD(0);
    for (int i = 0; i < nch; ++i) {
        const int r0 = rowbase + 64 * (dir ? (nch - 1 - i) : i);
        if (MODE == 2 && 2 * i == nch) {
            if (tid == 0) { unsigned sp = 0; while (__hip_atomic_load(peerflag, __ATOMIC_RELAXED, __HIP_MEMORY_SCOPE_AGENT) == 0u) { __builtin_amdgcn_s_sleep(2); if (++sp > (1u << 22)) break; } } }
        float cs0[8], cs1[8]; float run0 = 0.f, run1 = 0.f;
#pragma unroll
        for (int ii = 0; ii < 8; ++ii) { run0 += (float)lfv[ii].x; run1 += (float)lfv[ii].y; cs0[ii] = run0; cs1[ii] = run1; }
        *(GLAS f32x2*)(lds + TOT_OFF + (w * 128 + dk0) * 4) = (f32x2){run0, run1};
        __syncthreads();
        float pre0 = 0.f, pre1 = 0.f, br0 = 0.f, br1 = 0.f, bl0 = 0.f, bl1 = 0.f;
#pragma unroll
        for (int s = 0; s < 8; ++s) { const f32x2 t = *(const GLAS f32x2*)(lds + TOT_OFF + (s * 128 + dk0) * 4);
            if (s < w) { pre0 += t.x; pre1 += t.y; } if (s < 4) { br0 += t.x; br1 += t.y; } bl0 += t.x; bl1 += t.y; }
        const float c30 = __builtin_amdgcn_exp2f(bl0 - br0), c31 = __builtin_amdgcn_exp2f(bl1 - br1);
        if (w == 0) { *(GLAS f32x2*)(lds + EBR_OFF + dk0 * 4) = (f32x2){__builtin_amdgcn_exp2f(br0), __builtin_amdgcn_exp2f(br1)}; *(GLAS f32x2*)(lds + EBL_OFF + dk0 * 4) = (f32x2){__builtin_amdgcn_exp2f(bl0), __builtin_amdgcn_exp2f(bl1)}; }
        unsigned kh0[4], kh1[4], vt0[4], vt1[4];
#pragma unroll
        for (int ii = 0; ii < 8; ii += 2) {
            float ka[2], kb[2];
#pragma unroll
            for (int jj = 0; jj < 2; ++jj) { const int p = 8 * w + ii + jj;
                const float x0 = cs0[ii + jj] + pre0 - br0, x1 = cs1[ii + jj] + pre1 - br1;
                const float e10 = __builtin_amdgcn_exp2f(x0), e11 = __builtin_amdgcn_exp2f(x1), e20 = __builtin_amdgcn_exp2f(-x0), e21 = __builtin_amdgcn_exp2f(-x1);
                const float k0 = lo2f(kv[ii + jj]) * e20, k1 = hi2f(kv[ii + jj]) * e21;
                *(GLAS unsigned*)(lds + QT_OFF + p * QT_STR + pos0 * 2) = pkbf(lo2f(qv[ii + jj]) * e10, hi2f(qv[ii + jj]) * e11);
                *(GLAS unsigned*)(lds + KT_OFF + p * QT_STR + pos0 * 2) = pkbf(k0, k1);
                ka[jj] = k0 * c30; kb[jj] = k1 * c31; }
            kh0[ii >> 1] = pkbf(ka[0], ka[1]); kh1[ii >> 1] = pkbf(kb[0], kb[1]);
            vt0[ii >> 1] = (vv[ii] & 0xffffu) | (vv[ii + 1] << 16); vt1[ii >> 1] = (vv[ii] >> 16) | (vv[ii + 1] & 0xffff0000u);
        }
        *(GLAS u32x4*)(lds + KH_OFF + dk0 * KH_STR + 16 * w) = (u32x4){kh0[0], kh0[1], kh0[2], kh0[3]};
        *(GLAS u32x4*)(lds + KH_OFF + (dk0 + 1) * KH_STR + 16 * w) = (u32x4){kh1[0], kh1[1], kh1[2], kh1[3]};
        *(GLAS u32x4*)(lds + VT_OFF + dk0 * KH_STR + 16 * w) = (u32x4){vt0[0], vt0[1], vt0[2], vt0[3]};
        *(GLAS u32x4*)(lds + VT_OFF + (dk0 + 1) * KH_STR + 16 * w) = (u32x4){vt1[0], vt1[1], vt1[2], vt1[3]};
        if (i + 1 < nch) GLA_LOAD(i + 1);
        __syncthreads();
        { const int ti = w >> 1, si0 = 2 * (w & 1);
          bf16x8 sa[4], sb[4];
          if (si0 <= ti) {
#pragma unroll
            for (int ks = 0; ks < 4; ++ks) { sb[ks] = *(const GLAS bf16x8*)(lds + QT_OFF + (16 * ti + c) * QT_STR + 64 * ks + 16 * g); sa[ks] = *(const GLAS bf16x8*)(lds + KT_OFF + (16 * si0 + c) * QT_STR + 64 * ks + 16 * g); } }
#pragma unroll
          for (int q2 = 0; q2 < 2; ++q2) { const int si = si0 + q2; f32x4 a4 = (f32x4){0.f, 0.f, 0.f, 0.f};
            if (si <= ti) {
                if (q2 == 1) {
#pragma unroll
                    for (int ks = 0; ks < 4; ++ks) sa[ks] = *(const GLAS bf16x8*)(lds + KT_OFF + (16 * si + c) * QT_STR + 64 * ks + 16 * g); }
#pragma unroll
                for (int ks = 0; ks < 4; ++ks) a4 = __builtin_amdgcn_mfma_f32_16x16x32_bf16(sa[ks], sb[ks], a4, 0, 0, 0);
                if (si == ti) {
#pragma unroll
                    for (int r = 0; r < 4; ++r) if (4 * g + r > c) a4[r] = 0.f; }
            }
            *(GLAS u32x2*)(lds + AS_OFF + (16 * ti + c) * AS_STR + (16 * si + 4 * g) * 2) = (u32x2){pkbf(a4[0], a4[1]), pkbf(a4[2], a4[3])}; } }
        __syncthreads();
        const size_t cold = (size_t)h * 128 + 16 * w + 4 * g;
        const bool first_half = (MODE == 0) || (MODE == 2 && 2 * i < nch);
        u32x2 pf[4], gtv[4];
        if (!first_half) {
#pragma unroll
            for (int mt = 0; mt < 4; ++mt) { const int p = 16 * mt + c; const size_t ro = (size_t)(r0 + (dir ? 63 - p : p)) * 1024 + cold;
                if (MODE == 2) { const unsigned long long pv = __hip_atomic_load((const unsigned long long*)(T.OF + ro), __ATOMIC_RELAXED, __HIP_MEMORY_SCOPE_AGENT); pf[mt].x = (unsigned)pv; pf[mt].y = (unsigned)(pv >> 32); }
                else pf[mt] = *(const u32x2*)(T.OF + ro);
                gtv[mt] = *(const u32x2*)(T.GR + ro); }
        }
#define GSB() __builtin_amdgcn_sched_barrier(0)
#define LOADQ(qq, ee, ks) do { ee[0] = *(const GLAS f32x4*)(lds + EBR_OFF + (32 * (ks) + 4 * g) * 4); ee[1] = *(const GLAS f32x4*)(lds + EBR_OFF + (32 * (ks) + 16 + 4 * g) * 4); \
            _Pragma("unroll") for (int mt = 0; mt < 4; ++mt) qq[mt] = *(const GLAS bf16x8*)(lds + QT_OFF + (16 * mt + c) * QT_STR + 64 * (ks) + 16 * g); } while (0)
#define COMPQ(qq, ee, ks) do { const f32x4 s0v = S[2 * (ks)] * ee[0], s1v = S[2 * (ks) + 1] * ee[1]; \
            const u32x4 sw = (u32x4){pkbf(s0v[0], s0v[1]), pkbf(s0v[2], s0v[3]), pkbf(s1v[0], s1v[1]), pkbf(s1v[2], s1v[3])}; const bf16x8 sf = __builtin_bit_cast(bf16x8, sw); \
            _Pragma("unroll") for (int mt = 0; mt < 4; ++mt) o[mt] = __builtin_amdgcn_mfma_f32_16x16x32_bf16(sf, qq[mt], o[mt], 0, 0, 0); } while (0)
#define LOADK(kk, ll, t0) do { _Pragma("unroll") for (int t_ = 0; t_ < 2; ++t_) { ll[t_] = *(const GLAS f32x4*)(lds + EBL_OFF + (16 * ((t0) + t_) + 4 * g) * 4); \
            _Pragma("unroll") for (int sp = 0; sp < 2; ++sp) kk[t_][sp] = *(const GLAS bf16x8*)(lds + KH_OFF + (16 * ((t0) + t_) + c) * KH_STR + 64 * sp + 16 * g); } } while (0)
#define COMPK(kk, ll, t0) do { _Pragma("unroll") for (int t_ = 0; t_ < 2; ++t_) { S[(t0) + t_] = S[(t0) + t_] * ll[t_]; \
            _Pragma("unroll") for (int sp = 0; sp < 2; ++sp) S[(t0) + t_] = __builtin_amdgcn_mfma_f32_16x16x32_bf16(kk[t_][sp], vf[sp], S[(t0) + t_], 0, 0, 0); } } while (0)
        bf16x8 vf[2];
#pragma unroll
        for (int sp = 0; sp < 2; ++sp) vf[sp] = *(const GLAS bf16x8*)(lds + VT_OFF + (16 * w + c) * KH_STR + 64 * sp + 16 * g);
        f32x4 o[4];
#pragma unroll
        for (int mt = 0; mt < 4; ++mt) o[mt] = (f32x4){0.f, 0.f, 0.f, 0.f};
        { bf16x8 qA[4], qB[4]; f32x4 eA[2], eB[2];
          LOADQ(qA, eA, 0); LOADQ(qB, eB, 1); GSB();
          COMPQ(qA, eA, 0); GSB(); LOADQ(qA, eA, 2); GSB();
          COMPQ(qB, eB, 1); GSB(); LOADQ(qB, eB, 3); GSB();
          COMPQ(qA, eA, 2); GSB();
          bf16x8 af[6];
          af[0] = *(const GLAS bf16x8*)(lds + AS_OFF + (0 + c) * AS_STR + 16 * g); af[1] = *(const GLAS bf16x8*)(lds + AS_OFF + (16 + c) * AS_STR + 16 * g);
          af[2] = *(const GLAS bf16x8*)(lds + AS_OFF + (32 + c) * AS_STR + 16 * g); af[3] = *(const GLAS bf16x8*)(lds + AS_OFF + (32 + c) * AS_STR + 64 + 16 * g);
          af[4] = *(const GLAS bf16x8*)(lds + AS_OFF + (48 + c) * AS_STR + 16 * g); af[5] = *(const GLAS bf16x8*)(lds + AS_OFF + (48 + c) * AS_STR + 64 + 16 * g); GSB();
          COMPQ(qB, eB, 3); GSB();
          bf16x8 kA[2][2], kB[2][2]; f32x4 lA[2], lB[2];
          LOADK(kA, lA, 0); GSB();
          o[0] = __builtin_amdgcn_mfma_f32_16x16x32_bf16(vf[0], af[0], o[0], 0, 0, 0); o[1] = __builtin_amdgcn_mfma_f32_16x16x32_bf16(vf[0], af[1], o[1], 0, 0, 0);
          o[2] = __builtin_amdgcn_mfma_f32_16x16x32_bf16(vf[0], af[2], o[2], 0, 0, 0); o[2] = __builtin_amdgcn_mfma_f32_16x16x32_bf16(vf[1], af[3], o[2], 0, 0, 0);
          o[3] = __builtin_amdgcn_mfma_f32_16x16x32_bf16(vf[0], af[4], o[3], 0, 0, 0); o[3] = __builtin_amdgcn_mfma_f32_16x16x32_bf16(vf[1], af[5], o[3], 0, 0, 0); GSB();
          LOADK(kB, lB, 2); GSB(); COMPK(kA, lA, 0); GSB();
          LOADK(kA, lA, 4); GSB(); COMPK(kB, lB, 2); GSB();
          LOADK(kB, lB, 6); GSB(); COMPK(kA, lA, 4); GSB();
          COMPK(kB, lB, 6); GSB(); }
#undef LOADQ
#undef COMPQ
#undef LOADK
#undef COMPK
#undef GSB
        if (first_half) {
#pragma unroll
            for (int mt = 0; mt < 4; ++mt) { const int p = 16 * mt + c; const size_t ro = (size_t)(r0 + (dir ? 63 - p : p)) * 1024 + cold;
                const unsigned long long pv = (unsigned long long)pkbf(o[mt][0], o[mt][1]) | ((unsigned long long)pkbf(o[mt][2], o[mt][3]) << 32);
                if (MODE == 2) __hip_atomic_store((unsigned long long*)(T.OF + ro), pv, __ATOMIC_RELAXED, __HIP_MEMORY_SCOPE_AGENT);
                else *(unsigned long long*)(T.OF + ro) = pv; }
            if (MODE == 2 && 2 * (i + 1) == nch) {
                asm volatile("s_waitcnt vmcnt(0)" ::: "memory"); __syncthreads();
                if (tid == 0) __hip_atomic_store(myflag, 1u, __ATOMIC_RELAXED, __HIP_MEMORY_SCOPE_AGENT); }
        } else {

            float ss[4];
#pragma unroll
            for (int mt = 0; mt < 4; ++mt) { const int p = 16 * mt + c; const size_t ro = (size_t)(r0 + (dir ? 63 - p : p)) * 1024 + cold;
                o[mt][0] += lo2f(pf[mt].x); o[mt][1] += hi2f(pf[mt].x); o[mt][2] += lo2f(pf[mt].y); o[mt][3] += hi2f(pf[mt].y);
                float s = (o[mt][0] * o[mt][0] + o[mt][1] * o[mt][1]) + (o[mt][2] * o[mt][2] + o[mt][3] * o[mt][3]);
                s += __shfl_xor(s, 16); s += __shfl_xor(s, 32); ss[mt] = s;
                if (g == 0) *(GLAS float*)(lds + RS_OFF + (w * 64 + p) * 4) = s; }
            __syncthreads();
#pragma unroll
            for (int mt = 0; mt < 4; ++mt) { const int p = 16 * mt + c; float tot = 0.f;
#pragma unroll
                for (int ww = 0; ww < 8; ++ww) tot += *(const GLAS float*)(lds + RS_OFF + (ww * 64 + p) * 4);
                const float rinv = rsqrtf(tot * (1.0f / 128.0f) + 1e-6f);
                const size_t ro = (size_t)(r0 + (dir ? 63 - p : p)) * 1024 + cold;
                const u32x2 gt = gtv[mt];
                const float y0 = o[mt][0] * rinv * ng[0] * lo2f(gt.x), y1 = o[mt][1] * rinv * ng[1] * hi2f(gt.x), y2 = o[mt][2] * rinv * ng[2] * lo2f(gt.y), y3 = o[mt][3] * rinv * ng[3] * hi2f(gt.y);
                *(u32x2*)(T.GO + ro) = (u32x2){pkbf(y0, y1), pkbf(y2, y3)}; }
        }
    }
    if (sout) {
#pragma unroll
        for (int t = 0; t < 8; ++t)
#pragma unroll
            for (int r = 0; r < 4; ++r) sout[(size_t)(16 * t + 4 * g + r) * 128 + 16 * w + c] = S[t][r];
    }
}
#undef GLA_LOAD
#undef GLAS
}
struct Args { const float* in[19]; float* out; unsigned char* ws; int ph_lo, ph_hi, li, pad; };
__global__ void __launch_bounds__(NWAVES * 64, 2) mk_fwd(Args args) {
    extern __shared__ __attribute__((aligned(16))) unsigned char lds[];
    Frame F;
    F.lds = (LAS unsigned char*)lds;
    F.MISC = (volatile LAS unsigned*)(F.lds + MISC_OFF);
    F.tid = threadIdx.x; F.lane = F.tid & 63; F.wave = __builtin_amdgcn_readfirstlane(F.tid >> 6);
    F.G = gridDim.x; { const int bx = blockIdx.x; F.vcu = (F.G % 8 == 0) ? (bx % 8) * (F.G / 8) + bx / 8 : bx; }
    Ptrs P;
    P.x_prompt = args.in[0]; P.x_sample = args.in[1]; P.cache_k = args.in[2]; P.cache_v = args.in[3]; P.state_rec = args.in[4]; P.c = args.in[5]; P.c_ctx = args.in[6];
    P.ada_w = args.in[7]; P.ada_b = args.in[8]; P.attn_w_in = args.in[9]; P.attn_q_gain = args.in[10]; P.attn_k_gain = args.in[11]; P.attn_w_out = args.in[12];
    P.rec_w_in = args.in[13]; P.rec_lb = args.in[14]; P.rec_norm_gain = args.in[15]; P.rec_w_out = args.in[16]; P.ln_gain = args.in[17]; P.ln_bias = args.in[18];
    P.out = args.out; P.ws = args.ws;
    unsigned char* ws = args.ws;
    F.ctl = (gu32*)(ws + WS_CTL);
    for (int u = F.tid; u < (LDS_BYTES - LDSCTL_OFF) / 4; u += NWAVES * 64) ((LAS unsigned*)(F.lds + LDSCTL_OFF))[u] = 0u;
    __syncthreads();
    XcdBarrier bar; bar.bar = (unsigned*)(F.ctl + CW_BAR); bar.x = 0; bar.st = nullptr;
    if (N_LAUNCHES == 1) bar = xcd_barrier_post((unsigned*)(F.ctl + CW_BAR), F.MISC + 8);
#define GRID_BAR() do { if (N_LAUNCHES == 1) xcd_barrier(bar); } while (0)
    const int lo = args.ph_lo, hi = args.ph_hi;
#define IN(k) (lo <= (k) && (k) < hi)
#define BOTH(k) (IN(k) && IN((k) + 1))
#ifndef MK_REPEAT
#define MK_REPEAT (-1)
#endif
#define REP(k) _Pragma("unroll") for (int rep_ = 0; rep_ < ((MK_REPEAT == (k)) ? 2 : 1); ++rep_)
    bf16* const W1 = (bf16*)(ws + WS_W1); bf16* const W2 = (bf16*)(ws + WS_W2); bf16* const W3 = (bf16*)(ws + WS_W3); bf16* const W4 = (bf16*)(ws + WS_W4);
    bf16* const HA = (bf16*)(ws + WS_A); bf16* const QB_ = (bf16*)(ws + WS_B); bf16* const GC = (bf16*)(ws + WS_C); bf16* const AOD = (bf16*)(ws + WS_D);
    bf16* const Kall = (bf16*)(ws + WS_KALL); bf16* const Vall = (bf16*)(ws + WS_VALL);
    const float* const mod = (const float*)(ws + WS_MOD);
    float* const Y = P.out + OUT_Y;

    REP(0) if (IN(0)) { p0_prologue(F, P, rep_ == 0); if (BOTH(0)) GRID_BAR(); }
    REP(1) if (IN(1)) { p1_modulate(F, P); if (BOTH(1)) GRID_BAR(); }
    REP(2) if (IN(2)) {
        pg8::Gemm g{HA, W1, MTOK, N1, DM}; pg8::StaticOrder S; S.init(MTOK, N1, F.G, (int)blockIdx.x);
        pg8::EpiAttnIn E{QB_, Kall, Vall, GC, P.out + OUT_K, P.out + OUT_V, P.attn_q_gain, P.attn_k_gain, (const float*)(ws + WS_ROPE)};
        pg8::gemm_phase<pg8::EpiAttnIn, pg8::StaticOrder, true, true>(F.lds + RING_OFF, g, S, E);
        if (BOTH(2)) GRID_BAR();
    }
    REP(3) if (IN(3)) {
        typedef attn_body::bf16 abf;
        for (int v = F.vcu; v < 256; v += F.G) {
            { const int b = v >> 6, h = (v >> 2) & 15, qb = v & 3; const size_t qo = (size_t)(MP + b * L_S + qb * 256) * DM + h * 64; const size_t ko = (size_t)(MP + b * 1280) * 256 + (h >> 2) * 64;
              attn_body::attn_unit<8>((const abf*)QB_ + qo, (const abf*)Kall + ko, (const abf*)Vall + ko, 20, (abf*)AOD + qo, (const abf*)GC + qo, (char*)lds + RING_OFF); }
#pragma unroll 1
            for (int j = 0; j < 2; ++j) { const int u = 2 * v + j, b = u >> 4, h = u & 15; const size_t qo = (size_t)(b * L_P) * DM + h * 64; const size_t ko = (size_t)(b * L_P) * 256 + (h >> 2) * 64;
              attn_body::attn_unit<8>((const abf*)QB_ + qo, (const abf*)Kall + ko, (const abf*)Vall + ko, 4, (abf*)AOD + qo, (const abf*)GC + qo, (char*)lds + RING_OFF); }
        }
        if (BOTH(3)) GRID_BAR();
    }
    REP(4) if (IN(4)) {
        pg8::Gemm g{AOD, W2, MTOK, DM, DM}; pg8::StaticOrder S; S.init(MTOK, DM, F.G, (int)blockIdx.x);
        pg8::EpiRes E{P.x_prompt, P.x_sample, Y, mod + 2048};
        pg8::gemm_phase<pg8::EpiRes, pg8::StaticOrder, true, true>(F.lds + RING_OFF, g, S, E);
        if (BOTH(4)) GRID_BAR();
    }
    if (IN(5)) { p_layernorm<true>(F, P, Y, P.ln_gain, P.ln_bias, mod + 5 * 3072); if (BOTH(5)) GRID_BAR(); }
    REP(6) if (IN(6)) {
        pg8::Gemm g{HA, W3, MTOK, N3, DM}; pg8::StaticOrder S; S.init(MTOK, N3, F.G, (int)blockIdx.x);
        pg8::EpiRecIn E{QB_, (bf16*)(ws + WS_KR), GC, AOD, (_Float16*)(ws + WS_LF), P.rec_lb};
        pg8::gemm_phase<pg8::EpiRecIn, pg8::StaticOrder, true, true>(F.lds + RING_OFF, g, S, E);
        if (BOTH(6)) GRID_BAR();
    }
    REP(7) if (IN(7)) {
        gla::GlaT T{QB_, (const bf16*)(ws + WS_KR), GC, AOD, (const _Float16*)(ws + WS_LF), (bf16*)(ws + WS_OF), HA, P.rec_norm_gain};
        const int bx = blockIdx.x;
        if (F.G >= 128) {
            if (bx < 64) { const int u = bx, b = u >> 4, h = (u >> 1) & 7, dir = u & 1; const float* s0 = P.state_rec + ((size_t)(b * 2 + dir) * 8 + h) * 16384;
                gla::scan<2>(F.lds + RING_OFF, T, MP + b * L_S, L_S / 64, h, dir, s0, nullptr, (unsigned*)(F.ctl + CW_GLA + 64 * u), (unsigned*)(F.ctl + CW_GLA + 64 * (u ^ 1))); }
            else for (int u = bx - 64; u < 256; u += F.G - 64) { const int b = u >> 3, h = u & 7; float* so = P.out + OUT_S + ((size_t)(b * 2 + 0) * 8 + h) * 16384;
                gla::scan<0>(F.lds + RING_OFF, T, b * L_P, L_P / 64, h, 0, nullptr, so, nullptr, nullptr);
                gla::scan<1>(F.lds + RING_OFF, T, b * L_P, L_P / 64, h, 1, nullptr, so + 8 * 16384, nullptr, nullptr); }
        } else {
            for (int u = bx; u < 32 + 256; u += F.G) {
                if (u < 32) { const int b = u >> 3, h = u & 7; const float* s0 = P.state_rec + ((size_t)(b * 2 + 0) * 8 + h) * 16384;
                    gla::scan<0>(F.lds + RING_OFF, T, MP + b * L_S, L_S / 64, h, 0, s0, nullptr, nullptr, nullptr);
                    gla::scan<1>(F.lds + RING_OFF, T, MP + b * L_S, L_S / 64, h, 1, s0 + 8 * 16384, nullptr, nullptr, nullptr); }
                else { const int v = u - 32, b = v >> 3, h = v & 7; float* so = P.out + OUT_S + ((size_t)(b * 2 + 0) * 8 + h) * 16384;
                    gla::scan<0>(F.lds + RING_OFF, T, b * L_P, L_P / 64, h, 0, nullptr, so, nullptr, nullptr);
                    gla::scan<1>(F.lds + RING_OFF, T, b * L_P, L_P / 64, h, 1, nullptr, so + 8 * 16384, nullptr, nullptr); } }
        }
        if (BOTH(7)) GRID_BAR();
    }
    if (IN(8)) {
        pg8::Gemm g{HA, W4, MTOK, DM, DM}; pg8::StaticOrder S; S.init(MTOK, DM, F.G, (int)blockIdx.x);
        pg8::EpiRes E{Y, Y + (size_t)MP * DM, Y, mod + 5 * 3072 + 2048};
        pg8::gemm_phase<pg8::EpiRes, pg8::StaticOrder, true, true>(F.lds + RING_OFF, g, S, E);
        if (BOTH(8)) GRID_BAR();
    }
    if (IN(9)) { p_layernorm<false>(F, P, Y, P.ln_gain + DM, P.ln_bias + DM, mod); }
#undef IN
#undef BOTH
#undef GRID_BAR
}

extern "C" void kernel_launch(void* const* d_in, const int* in_sizes, int n_in, void* d_out, int out_size, void* d_ws, size_t ws_size, hipStream_t stream) {
    static int grid = 0;
    if (grid == 0) {
        if (n_in != 19 || in_sizes[0] != MP * DM || in_sizes[1] != NB_S * L_S * DM || (size_t)out_size != OUT_END || ws_size < WS_END) {
            fprintf(stderr, "kernel_launch: unexpected shapes: n_in %d in0 %d in1 %d out %d ws %zu; nothing launched\n", n_in, n_in > 0 ? in_sizes[0] : -1, n_in > 1 ? in_sizes[1] : -1, out_size, ws_size); grid = -1; return; }
        int dev = 0, cus = 0, per_cu = 0;
        if (hipGetDevice(&dev) != hipSuccess || hipDeviceGetAttribute(&cus, hipDeviceAttributeMultiprocessorCount, dev) != hipSuccess) { fprintf(stderr, "kernel_launch: device query failed\n"); grid = -1; return; }
        if (hipFuncSetAttribute((const void*)mk_fwd, hipFuncAttributeMaxDynamicSharedMemorySize, LDS_BYTES) != hipSuccess) { fprintf(stderr, "kernel_launch: hipFuncSetAttribute failed\n"); grid = -1; return; }
        if (hipOccupancyMaxActiveBlocksPerMultiprocessor(&per_cu, (const void*)mk_fwd, NWAVES * 64, LDS_BYTES) != hipSuccess || per_cu < 1)
            fprintf(stderr, "kernel_launch: note: occupancy query reports %d workgroups per CU\n", per_cu);
        (void)hipGetLastError();
        grid = cus;
    }
    if (grid < 0) return;
    if (hipMemsetAsync((char*)d_ws + WS_CTL, 0, CTL_ZERO_BYTES, stream) != hipSuccess) { fprintf(stderr, "kernel_launch: memset failed\n"); return; }
    Args a{};
    for (int i = 0; i < 19; ++i) a.in[i] = (const float*)d_in[i];
    a.out = (float*)d_out; a.ws = (unsigned char*)d_ws;
    for (int li = 0; li < N_LAUNCHES; ++li) {
        a.ph_lo = (N_LAUNCHES == 1) ? 0 : li; a.ph_hi = (N_LAUNCHES == 1) ? NPHASE : li + 1; a.li = li;
        hipLaunchKernelGGL(mk_fwd, dim3(grid), dim3(NWAVES * 64), LDS_BYTES, stream, a);
        const hipError_t le = hipPeekAtLastError();
        if (le != hipSuccess) { fprintf(stderr, "kernel_launch: launch %d failed: %s\n", li, hipGetErrorName(le)); break; }
    }
}
```

```cpp
#include <hip/hip_runtime.h>
#include <hip/hip_bf16.h>
#include <cstdio>
#include <cstdint>
#include <cmath>
#ifndef MK_N_LAUNCHES
#define MK_N_LAUNCHES 1
#endif
namespace pg8 {
#define PG8_LAS __attribute__((address_space(3)))
typedef unsigned short bf16_t;
typedef short bf16x8 __attribute__((ext_vector_type(8)));
typedef float f32x4 __attribute__((ext_vector_type(4)));
typedef unsigned u32x4 __attribute__((ext_vector_type(4)));
constexpr int BM = 256, BK = 64, HALF = 128, HTB = HALF * BK * 2  , STAGE_BYTES = 8 * HTB, NXCD = 8, WGM = 8;

__host__ __device__ __forceinline__ int lds_byte(int r, int c) { const int st = (r >> 4) * 2 + (c >> 5), rr = r & 15, cc = c & 31, ob = rr * 64 + cc * 2; return st * 1024 + (ob ^ (((ob >> 9) & 1) << 5)); }
__host__ __device__ __forceinline__ void stage_rc(int b, int& R, int& C) { const int st = b / 1024, sb = b % 1024, swz = sb ^ (((sb >> 9) & 1) << 5); R = (st >> 1) * 16 + swz / 64; C = (st & 1) * 32 + (swz % 64) / 2; }
__host__ __device__ __forceinline__ int perm32(int rho) { const int n = rho >> 4, i = rho & 15; return 8 * (i >> 2) + 4 * n + (i & 3); }

struct Unit { int pm, pn; };
struct Gemm { const bf16_t* A; const bf16_t* Bt; int M, N, K; };

struct StaticOrder {
    int nM, nN, nwg, G, c;
    __host__ __device__ void init(int M, int N, int G_, int c_) { nM = M / BM; nN = N / BM; nwg = nM * nN; G = G_; c = c_; }
    __host__ __device__ bool next(int i, Unit& u) const {
        const long L = (long)i * G + c; if (L >= nwg) return false;
        int wgid = (int)L; { const int q = nwg / NXCD, r = nwg % NXCD, xcd = wgid % NXCD, off = wgid / NXCD; wgid = (xcd < r ? xcd * (q + 1) : r * (q + 1) + (xcd - r) * q) + off; }
        const int nig = WGM * nN, gid = wgid / nig, fm = gid * WGM, gsz = (nM - fm) < WGM ? (nM - fm) : WGM;
        u.pm = fm + ((wgid % nig) % gsz); u.pn = (wgid % nig) / gsz; return true;
    }
    __device__ __forceinline__ void a_ready(const Unit&) const {}
    __device__ __forceinline__ void done(const Unit&) const {}
};
__device__ __forceinline__ unsigned cvt_pk_bf16(float lo, float hi) { unsigned r; asm volatile("v_cvt_pk_bf16_f32 %0, %1, %2" : "=v"(r) : "v"(lo), "v"(hi)); return r; }
typedef unsigned u32x2 __attribute__((ext_vector_type(2)));
typedef _Float16 f16x8 __attribute__((ext_vector_type(8)));
__device__ __forceinline__ float siluf(float x) { return x / (1.f + __expf(-x)); }
__device__ __forceinline__ u32x2 pk4(const f32x4 x) { u32x2 w; w.x = cvt_pk_bf16(x[0], x[1]); w.y = cvt_pk_bf16(x[2], x[3]); return w; }
__device__ __forceinline__ u32x4 pk8(const f32x4 a, const f32x4 b) { u32x4 w; w.x = cvt_pk_bf16(a[0], a[1]); w.y = cvt_pk_bf16(a[2], a[3]); w.z = cvt_pk_bf16(b[0], b[1]); w.w = cvt_pk_bf16(b[2], b[3]); return w; }
constexpr float ATT_C2 = 0.125f * 1.4426950408889634f;
constexpr int MROWS = 12288, MPROMPT = 8192;
struct EpiAttnIn {
    static constexpr bool PERM = false, AFTER_DRAIN = false;
    bf16_t *Q, *Kall, *Vall, *G; float *outK, *outV; const float *qgain, *kgain, *rope;
    __device__ __forceinline__ void operator()(const f32x4 (&acc)[2][2][4][2], const Unit& u, int wr, int wc, int fr, int fq) const {
        const int pn = u.pn; const bool samp = u.pm >= 32;
        const int rbase = u.pm * BM + wr * 64 + fr;
        if (pn <= 4) {
            const bool isq = pn < 4; const float* gain = isq ? qgain : kgain;
            f32x4 gv[2][2];
#pragma unroll
            for (int bj = 0; bj < 2; ++bj)
#pragma unroll
                for (int n = 0; n < 2; ++n) gv[bj][n] = *(const f32x4*)(gain + 32 * bj + 16 * n + 4 * fq);
#pragma unroll
            for (int ai = 0; ai < 2; ++ai)
#pragma unroll
                for (int m = 0; m < 4; ++m) {
                    const int r = rbase + ai * HALF + m * 16;
                    f32x4 v[2][2]; float ss = 0.f;
#pragma unroll
                    for (int bj = 0; bj < 2; ++bj)
#pragma unroll
                        for (int n = 0; n < 2; ++n) { const f32x4 x = acc[ai][bj][m][n]; v[bj][n] = x; ss += (x[0] * x[0] + x[1] * x[1]) + (x[2] * x[2] + x[3] * x[3]); }
                    ss += __shfl_xor(ss, 16); ss += __shfl_xor(ss, 32);
                    const float rinv = rsqrtf(ss * (1.0f / 64.0f) + 1e-6f);
#pragma unroll
                    for (int bj = 0; bj < 2; ++bj)
#pragma unroll
                        for (int n = 0; n < 2; ++n) v[bj][n] = v[bj][n] * rinv * gv[bj][n];
                    int krow = r;
                    if (samp) {
                        const int rs = r - MPROMPT, t = rs & 1023, b = rs >> 10; krow = MPROMPT + b * 1280 + 256 + t;
#pragma unroll
                        for (int bj = 0; bj < 2; ++bj) { const int pos = bj ? (t & 63) : (t >> 6);
                            const f32x4 cs = *(const f32x4*)(rope + pos * 32 + 4 * fq), sn = *(const f32x4*)(rope + pos * 32 + 16 + 4 * fq);
                            const f32x4 a = v[bj][0], b2 = v[bj][1]; v[bj][0] = a * cs - b2 * sn; v[bj][1] = b2 * cs + a * sn; }
                    }
                    if (isq) { bf16_t* dst = Q + (size_t)r * 1024 + pn * 256 + wc * 64 + 4 * fq;
#pragma unroll
                        for (int bj = 0; bj < 2; ++bj)
#pragma unroll
                            for (int n = 0; n < 2; ++n) *(u32x2*)(dst + 32 * bj + 16 * n) = pk4(v[bj][n] * ATT_C2);
                    } else {
                        if (!samp) { float* dk = outK + (size_t)r * 256 + wc * 64 + 4 * fq;
#pragma unroll
                            for (int bj = 0; bj < 2; ++bj)
#pragma unroll
                                for (int n = 0; n < 2; ++n) *(f32x4*)(dk + 32 * bj + 16 * n) = v[bj][n]; }
                        bf16_t* dst = Kall + (size_t)krow * 256 + wc * 64 + 4 * fq;
#pragma unroll
                        for (int bj = 0; bj < 2; ++bj)
#pragma unroll
                            for (int n = 0; n < 2; ++n) *(u32x2*)(dst + 32 * bj + 16 * n) = pk4(v[bj][n]);
                    }
                }
        } else if (pn == 5) {
#pragma unroll
            for (int ai = 0; ai < 2; ++ai)
#pragma unroll
                for (int m = 0; m < 4; ++m) {
                    const int r = rbase + ai * HALF + m * 16; int vrow = r;
                    if (samp) { const int rs = r - MPROMPT; vrow = MPROMPT + (rs >> 10) * 1280 + 256 + (rs & 1023); }
#pragma unroll
                    for (int bj = 0; bj < 2; ++bj) { const int L = 128 * bj + 32 * wc + 8 * fq; const f32x4 x0 = acc[ai][bj][m][0], x1 = acc[ai][bj][m][1];
                        if (!samp) { *(f32x4*)(outV + (size_t)r * 256 + L) = x0; *(f32x4*)(outV + (size_t)r * 256 + L + 4) = x1; }
                        *(u32x4*)(Vall + (size_t)vrow * 256 + L) = pk8(x0, x1); }
                }
        } else {
#pragma unroll
            for (int ai = 0; ai < 2; ++ai)
#pragma unroll
                for (int m = 0; m < 4; ++m) {
                    const int r = rbase + ai * HALF + m * 16;
#pragma unroll
                    for (int bj = 0; bj < 2; ++bj) { f32x4 x0 = acc[ai][bj][m][0], x1 = acc[ai][bj][m][1];
#pragma unroll
                        for (int e = 0; e < 4; ++e) { x0[e] = siluf(x0[e]); x1[e] = siluf(x1[e]); }
                        *(u32x4*)(G + (size_t)r * 1024 + (pn - 6) * 256 + 128 * bj + 32 * wc + 8 * fq) = pk8(x0, x1); }
                }
        }
    }
};
struct EpiRes {
    static constexpr bool PERM = false, AFTER_DRAIN = false;
    const float *xp, *xs; float* Y; const float* gate;
    __device__ __forceinline__ void operator()(const f32x4 (&acc)[2][2][4][2], const Unit& u, int wr, int wc, int fr, int fq) const {
        const int cond = u.pm < 32 ? 0 : 1 + ((u.pm - 32) >> 2);
        const int col0 = u.pn * BM + wc * 32 + 4 * fq, rbase = u.pm * BM + wr * 64 + fr;
        f32x4 g4[2][2];
#pragma unroll
        for (int bj = 0; bj < 2; ++bj)
#pragma unroll
            for (int n = 0; n < 2; ++n) g4[bj][n] = *(const f32x4*)(gate + cond * 3072 + col0 + bj * HALF + n * 16);
#pragma unroll
        for (int ai = 0; ai < 2; ++ai)
#pragma unroll
            for (int m = 0; m < 4; ++m) {
                const int r = rbase + ai * HALF + m * 16;
                const float* xr = (r < MPROMPT ? xp + (size_t)r * 1024 : xs + (size_t)(r - MPROMPT) * 1024) + col0;
                float* yr = Y + (size_t)r * 1024 + col0;
#pragma unroll
                for (int bj = 0; bj < 2; ++bj)
#pragma unroll
                    for (int n = 0; n < 2; ++n) { const f32x4 x = *(const f32x4*)(xr + bj * HALF + n * 16); *(f32x4*)(yr + bj * HALF + n * 16) = x * 1.41421356237f + g4[bj][n] * acc[ai][bj][m][n]; }
            }
    }
};
struct EpiRecIn {
    static constexpr bool PERM = false, AFTER_DRAIN = false;
    bf16_t *QR, *VR, *GR; _Float16* Z;
    __device__ __forceinline__ void operator()(const f32x4 (&acc)[2][2][4][2], const Unit& u, int wr, int wc, int fr, int fq) const {
        const int type = u.pn >> 2, cb = (u.pn & 3) * 256 + 32 * wc + 8 * fq, rbase = u.pm * BM + wr * 64 + fr;
        if (type == 1 || type == 2) {
            const int d = type - 1;
#pragma unroll
            for (int ai = 0; ai < 2; ++ai)
#pragma unroll
                for (int m = 0; m < 4; ++m) {
                    const size_t ro = ((size_t)d * MROWS + (rbase + ai * HALF + m * 16)) * 1024 + cb;
#pragma unroll
                    for (int bj = 0; bj < 2; ++bj) { f16x8 zz;
#pragma unroll
                        for (int e = 0; e < 4; ++e) { zz[e] = (_Float16)acc[ai][bj][m][0][e]; zz[4 + e] = (_Float16)acc[ai][bj][m][1][e]; }
                        *(f16x8*)(Z + ro + 128 * bj) = zz; }
                }
        } else if (type == 0) { plain<true>(QR, acc, rbase, cb);
        } else if (type == 3) { plain<false>(VR, acc, rbase, cb);
        } else { plain<true>(GR, acc, rbase, cb); }
    }
    template <bool ACT> __device__ __forceinline__ void plain(bf16_t* dstb, const f32x4 (&acc)[2][2][4][2], int rbase, int cb) const {
#pragma unroll
        for (int ai = 0; ai < 2; ++ai)
#pragma unroll
            for (int m = 0; m < 4; ++m) {
                const size_t ro = (size_t)(rbase + ai * HALF + m * 16) * 1024 + cb;
#pragma unroll
                for (int bj = 0; bj < 2; ++bj) { f32x4 x0 = acc[ai][bj][m][0], x1 = acc[ai][bj][m][1];
                    if (ACT) {
#pragma unroll
                        for (int e = 0; e < 4; ++e) { x0[e] = siluf(x0[e]); x1[e] = siluf(x1[e]); } }
                    *(u32x4*)(dstb + ro + 128 * bj) = pk8(x0, x1); }
            }
    }
};
template <class Epi, class Sched, bool ALIGN_EPI = false, bool SP2 = false>
__device__ __forceinline__ void gemm_phase(PG8_LAS unsigned char* lds, const Gemm g, const Sched& S, const Epi& E) {
    int tid_ = threadIdx.x; asm volatile("" : "+v"(tid_));
    const int tid = tid_, wid = __builtin_amdgcn_readfirstlane(tid >> 6), lane = tid & 63, wr = wid >> 2, wc = wid & 3, fr = lane & 15, fq = lane >> 4;
    const int K = g.K, nt = K / BK;
    unsigned voffA[2], voffB[2];
#pragma unroll
    for (int i = 0; i < 2; ++i) { int R, C; stage_rc(tid * 16 + i * 8192, R, C); const int Rb = Epi::PERM ? ((R & ~31) + perm32(R & 31)) : R;
        voffA[i] = (unsigned)(R * K + C) * 2u; voffB[i] = (unsigned)(Rb * K + C) * 2u; }
    const size_t kstep = (size_t)(BK * 2);
    const size_t hstep = (size_t)HALF * K * 2;
    const size_t tstep = 2 * hstep;
    const unsigned ldsw = (unsigned)wid * 1024u;
    const int aoff = lds_byte(wr * 64 + fr, fq * 8), boff = lds_byte(wc * 32 + fr, fq * 8);
#define PG8_SA(b, h) (((b) * 2 + (h)) * HTB)
#define PG8_SB(b, h) ((4 + (b) * 2 + (h)) * HTB)
#define PG8_STAGE(bufoff, gbase, voff) do { _Pragma("unroll") for (int _i = 0; _i < 2; ++_i) \
        __builtin_amdgcn_global_load_lds((const unsigned*)((const char*)(gbase) + (voff)[_i]), (PG8_LAS unsigned*)(lds + (bufoff) + ldsw + _i * 8192), 16, 0, 0); } while (0)
#define PG8_LDA(dst, b, h) do { _Pragma("unroll") for (int m = 0; m < 4; ++m) _Pragma("unroll") for (int k = 0; k < 2; ++k) dst[m][k] = *(const PG8_LAS bf16x8*)(lds + PG8_SA(b, h) + aoff + m * 2048 + k * 1024); } while (0)
#define PG8_LDB(dst, b, h) do { _Pragma("unroll") for (int n = 0; n < 2; ++n) _Pragma("unroll") for (int k = 0; k < 2; ++k) dst[n][k] = *(const PG8_LAS bf16x8*)(lds + PG8_SB(b, h) + boff + n * 2048 + k * 1024); } while (0)
#define PG8_MMA(ai, bj, At, Bt) do { __builtin_amdgcn_s_setprio(1); _Pragma("unroll") for (int m = 0; m < 4; ++m) _Pragma("unroll") for (int n = 0; n < 2; ++n) _Pragma("unroll") for (int k = 0; k < 2; ++k) \
        acc[ai][bj][m][n] = __builtin_amdgcn_mfma_f32_16x16x32_bf16(Bt[n][k], At[m][k], acc[ai][bj][m][n], 0, 0, 0); __builtin_amdgcn_s_setprio(0); } while (0)
#define PG8_WAIT_V(n) asm volatile("s_waitcnt vmcnt(" #n ")" ::: "memory")
#define PG8_WAIT_L(n) asm volatile("s_waitcnt lgkmcnt(" #n ")" ::: "memory")
#define PG8_BAR __builtin_amdgcn_s_barrier()
#define PG8_SCHED __builtin_amdgcn_sched_barrier(0)
    Unit cur, nxt; int ui = 0;
    if (!S.next(0, cur)) return;
    f32x4 acc[2][2][4][2];
#pragma unroll
    for (int a = 0; a < 2; ++a)
#pragma unroll
        for (int b = 0; b < 2; ++b)
#pragma unroll
            for (int m = 0; m < 4; ++m)
#pragma unroll
                for (int n = 0; n < 2; ++n) acc[a][b][m][n] = (f32x4){0.f, 0.f, 0.f, 0.f};
    bf16x8 At[4][2], B0[2][2], B1[2][2];
    const char* cA = (const char*)g.A + (size_t)cur.pm * tstep; const char* cB = (const char*)g.Bt + (size_t)cur.pn * tstep;
    S.a_ready(cur);
    if constexpr (SP2) {
        PG8_STAGE(PG8_SB(0, 0), cB, voffB); PG8_STAGE(PG8_SB(0, 1), cB + hstep, voffB); PG8_STAGE(PG8_SA(0, 0), cA, voffA); PG8_STAGE(PG8_SA(0, 1), cA + hstep, voffA);
        if (wr == 1) PG8_BAR;
        PG8_WAIT_V(2); PG8_BAR;
        PG8_STAGE(PG8_SB(1, 0), cB + kstep, voffB); PG8_STAGE(PG8_SA(1, 0), cA + kstep, voffA); PG8_STAGE(PG8_SB(1, 1), cB + hstep + kstep, voffB);
        PG8_WAIT_V(6); PG8_BAR;
    } else {
        PG8_STAGE(PG8_SB(0, 0), cB, voffB); PG8_STAGE(PG8_SA(0, 0), cA, voffA); PG8_STAGE(PG8_SB(0, 1), cB + hstep, voffB); PG8_STAGE(PG8_SA(0, 1), cA + hstep, voffA);
        if (wr == 1) PG8_BAR;
        PG8_WAIT_V(4); PG8_BAR;
        PG8_STAGE(PG8_SB(1, 0), cB + kstep, voffB); PG8_STAGE(PG8_SA(1, 0), cA + kstep, voffA); PG8_STAGE(PG8_SB(1, 1), cB + hstep + kstep, voffB);
        PG8_WAIT_V(6); PG8_BAR;
    }
    for (;;) {
        const bool has_next = S.next(ui + 1, nxt);
        const char* nA = has_next ? (const char*)g.A + (size_t)nxt.pm * tstep : cA; const char* nB = has_next ? (const char*)g.Bt + (size_t)nxt.pn * tstep : cB;
        for (int t = 0; t < nt; t += 2) {
            const bool last = (t == nt - 2);
            const char* a1 = cA + (size_t)(t + 1) * kstep;
            const char* a2 = last ? nA : cA + (size_t)(t + 2) * kstep; const char* b2 = last ? nB : cB + (size_t)(t + 2) * kstep;
            const char* a3 = a2 + kstep; const char* b3 = b2 + kstep;
            if (last && has_next) S.a_ready(nxt);
            if constexpr (SP2) {
            PG8_LDB(B0, 0, 0); PG8_LDB(B1, 0, 1); PG8_SCHED; PG8_LDA(At, 0, 0); PG8_STAGE(PG8_SA(1, 1), a1 + hstep, voffA);
            PG8_WAIT_V(8); PG8_WAIT_L(0); PG8_BAR; PG8_MMA(0, 0, At, B0); PG8_MMA(0, 1, At, B1); PG8_BAR; PG8_SCHED;
            PG8_LDA(At, 0, 1); PG8_STAGE(PG8_SB(0, 0), b2, voffB); PG8_STAGE(PG8_SB(0, 1), b2 + hstep, voffB); PG8_STAGE(PG8_SA(0, 0), a2, voffA);
            PG8_WAIT_V(8); PG8_WAIT_L(0); PG8_BAR; PG8_MMA(1, 0, At, B0); PG8_MMA(1, 1, At, B1); PG8_BAR; PG8_SCHED;
            PG8_LDB(B0, 1, 0); PG8_LDB(B1, 1, 1); PG8_SCHED; PG8_LDA(At, 1, 0); PG8_STAGE(PG8_SA(0, 1), a2 + hstep, voffA);
            PG8_WAIT_V(8); PG8_WAIT_L(0); PG8_BAR; PG8_MMA(0, 0, At, B0); PG8_MMA(0, 1, At, B1); PG8_BAR; PG8_SCHED;
            PG8_LDA(At, 1, 1); PG8_STAGE(PG8_SB(1, 0), b3, voffB); PG8_STAGE(PG8_SB(1, 1), b3 + hstep, voffB); PG8_STAGE(PG8_SA(1, 0), a3, voffA);
            PG8_WAIT_V(8); PG8_WAIT_L(0); PG8_BAR; PG8_MMA(1, 0, At, B0); PG8_MMA(1, 1, At, B1); PG8_BAR; PG8_SCHED;
            } else {
            PG8_LDB(B0, 0, 0); PG8_SCHED; PG8_LDA(At, 0, 0); PG8_STAGE(PG8_SA(1, 1), a1 + hstep, voffA);
            PG8_WAIT_L(8); PG8_BAR; PG8_WAIT_L(0); PG8_MMA(0, 0, At, B0); PG8_BAR; PG8_SCHED;
            PG8_LDB(B1, 0, 1); PG8_STAGE(PG8_SB(0, 0), b2, voffB);
            PG8_BAR; PG8_WAIT_L(0); PG8_MMA(0, 1, At, B1); PG8_BAR;
            PG8_LDA(At, 0, 1); PG8_STAGE(PG8_SA(0, 0), a2, voffA);
            PG8_BAR; PG8_WAIT_L(0); PG8_MMA(1, 0, At, B0); PG8_BAR; PG8_SCHED;
            PG8_STAGE(PG8_SB(0, 1), b2 + hstep, voffB);
            PG8_WAIT_V(6); PG8_BAR; PG8_MMA(1, 1, At, B1); PG8_BAR;
            PG8_LDB(B0, 1, 0); PG8_SCHED; PG8_LDA(At, 1, 0); PG8_STAGE(PG8_SA(0, 1), a2 + hstep, voffA);
            PG8_WAIT_L(8); PG8_BAR; PG8_WAIT_L(0); PG8_MMA(0, 0, At, B0); PG8_BAR; PG8_SCHED;
            PG8_LDB(B1, 1, 1); PG8_STAGE(PG8_SB(1, 0), b3, voffB);
            PG8_BAR; PG8_WAIT_L(0); PG8_MMA(0, 1, At, B1); PG8_BAR;
            PG8_LDA(At, 1, 1); PG8_STAGE(PG8_SA(1, 0), a3, voffA);
            PG8_BAR; PG8_WAIT_L(0); PG8_MMA(1, 0, At, B0); PG8_BAR; PG8_SCHED;
            PG8_STAGE(PG8_SB(1, 1), b3 + hstep, voffB);
            PG8_WAIT_V(6); PG8_BAR; PG8_MMA(1, 1, At, B1); PG8_BAR;
            }
        }
        if constexpr (ALIGN_EPI) { if (wr == 0) PG8_BAR; }
        if constexpr (!Epi::AFTER_DRAIN) { E(acc, cur, wr, wc, fr, fq); S.done(cur); }
        if (!has_next) break;
#pragma unroll
        for (int a = 0; a < 2; ++a)
#pragma unroll
            for (int b = 0; b < 2; ++b)
#pragma unroll
                for (int m = 0; m < 4; ++m)
#pragma unroll
                    for (int n = 0; n < 2; ++n) acc[a][b][m][n] = (f32x4){0.f, 0.f, 0.f, 0.f};
        cur = nxt; cA = nA; cB = nB; ++ui;
        if constexpr (ALIGN_EPI) { if (wr == 1) PG8_BAR; }
    }
    PG8_WAIT_V(0);
    if constexpr (!ALIGN_EPI) { if (wr == 0) PG8_BAR; }
    PG8_BAR;
    if constexpr (Epi::AFTER_DRAIN) { E.fused(acc, cur, wr, wc, fr, fq, lds, wid, lane); S.done(cur); }
#undef PG8_SA
#undef PG8_SB
#undef PG8_STAGE
#undef PG8_LDA
#undef PG8_LDB
#undef PG8_MMA
#undef PG8_WAIT_V
#undef PG8_WAIT_L
#undef PG8_BAR
#undef PG8_SCHED
}
}
#include <hip/hip_bf16.h>
namespace attn_body {
using bf16=__hip_bfloat16;
using bf16x8=__attribute__((ext_vector_type(8)))short;
using s16x4=__attribute__((ext_vector_type(4)))short;
using f32x16=__attribute__((ext_vector_type(16)))float;
using u32x4=__attribute__((ext_vector_type(4)))unsigned;
constexpr int D=64,QP=1024,KVP=256;
constexpr int NW=8,QBLK=32,QB=QBLK*NW,KVBLK=64;
__device__ __forceinline__ int crow(int r,int hi){return (r&3)+8*(r>>2)+4*hi;}
#define SBAR() __builtin_amdgcn_sched_barrier(0)
constexpr int NSLOT=3, SLOTB=8192;
constexpr int LDS_K=0, LDS_V=NSLOT*SLOTB, LDS_WS=2*NSLOT*SLOTB, LDS_OST=LDS_WS+NW*64*4, LDS_BYTES=LDS_OST+NW*4096;
constexpr float C2=0.125f*1.4426950408889634f;
__device__ __forceinline__ void glds16(const void*gsrc,unsigned lds_dst){unsigned keep;
  asm volatile("s_mov_b32 %0, m0\n\ts_mov_b32 m0, %2\n\ts_nop 0\n\tglobal_load_lds_dwordx4 %1, off\n\ts_mov_b32 m0, %0":"=&s"(keep):"v"(gsrc),"s"(lds_dst):"memory");}
__device__ __forceinline__ float max3f(float a,float b,float c){float r;asm("v_max3_f32 %0, %1, %2, %3":"=v"(r):"v"(a),"v"(b),"v"(c));return r;}
__device__ __forceinline__ float max2f(float a,float b){float r;asm("v_max_f32_e32 %0, %1, %2":"=v"(r):"v"(a),"v"(b));return r;}
__device__ __forceinline__ float fadd_s(float a,float b){float r;asm("v_add_f32_e32 %0, %1, %2":"=v"(r):"v"(a),"v"(b));return r;}
__device__ __forceinline__ float fsub_s(float a,float b){float r;asm("v_sub_f32_e32 %0, %1, %2":"=v"(r):"v"(a),"v"(b));return r;}
typedef float f32x2_t __attribute__((ext_vector_type(2))); typedef __bf16 bf16x2_t __attribute__((ext_vector_type(2)));
__device__ __forceinline__ unsigned cvtpk_s(float lo,float hi){f32x2_t v={lo,hi};bf16x2_t b=__builtin_convertvector(v,bf16x2_t);return __builtin_bit_cast(unsigned,b);}
#define WAIT_BAR(N) asm volatile("s_waitcnt vmcnt(" #N ") lgkmcnt(0)\n\ts_barrier":::"memory")

__device__ __forceinline__ void qkt(f32x16&p0,f32x16&p1,const char*Kslot,const bf16x8*qr,const f32x16&negm,int r32,int hi){
  const char*kb=Kslot+hi*1024+r32*16;
  #pragma unroll
  for(int d0=0;d0<4;++d0){
    const bf16x8 b0=*reinterpret_cast<const bf16x8*>(kb+d0*2048);
    const bf16x8 b1=*reinterpret_cast<const bf16x8*>(kb+d0*2048+512);
    if(d0==0){p0=__builtin_amdgcn_mfma_f32_32x32x16_bf16(b0,qr[0],negm,0,0,0);p1=__builtin_amdgcn_mfma_f32_32x32x16_bf16(b1,qr[0],negm,0,0,0);}
    else{p0=__builtin_amdgcn_mfma_f32_32x32x16_bf16(b0,qr[d0],p0,0,0,0);p1=__builtin_amdgcn_mfma_f32_32x32x16_bf16(b1,qr[d0],p1,0,0,0);}}
}
typedef __attribute__((address_space(3))) const char* lds_cptr;
typedef short v4i16_t __attribute__((ext_vector_type(4)));
__device__ __forceinline__ void kload8(bf16x8*kf,lds_cptr kp){
  kf[0]=*(const __attribute__((address_space(3))) bf16x8*)(kp);      kf[1]=*(const __attribute__((address_space(3))) bf16x8*)(kp+512);
  kf[2]=*(const __attribute__((address_space(3))) bf16x8*)(kp+2048); kf[3]=*(const __attribute__((address_space(3))) bf16x8*)(kp+2560);
  kf[4]=*(const __attribute__((address_space(3))) bf16x8*)(kp+4096); kf[5]=*(const __attribute__((address_space(3))) bf16x8*)(kp+4608);
  kf[6]=*(const __attribute__((address_space(3))) bf16x8*)(kp+6144); kf[7]=*(const __attribute__((address_space(3))) bf16x8*)(kp+6656);
}
__device__ __forceinline__ void kload2(bf16x8*kf,lds_cptr kp,int j){ kf[2*j]=*(const __attribute__((address_space(3))) bf16x8*)(kp+j*2048); kf[2*j+1]=*(const __attribute__((address_space(3))) bf16x8*)(kp+j*2048+512); }
__device__ __forceinline__ s16x4 vtr(lds_cptr p){ return __builtin_bit_cast(s16x4,__builtin_amdgcn_ds_read_tr16_b64_v4i16((__attribute__((address_space(3))) v4i16_t*)p)); }
__device__ __forceinline__ float rowmax(const f32x16&p0,const f32x16&p1){
  float a=max3f(p0[0],p0[1],p1[0]),b=max3f(p0[2],p0[3],p1[1]);a=max3f(a,p1[2],p1[3]);
  #pragma unroll
  for(int r=4;r<16;r+=4){a=max3f(a,p0[r],p0[r+1]);b=max3f(b,p0[r+2],p0[r+3]);a=max3f(a,p1[r],p1[r+1]);b=max3f(b,p1[r+2],p1[r+3]);}
  const float m=max2f(a,b);
  auto rr=__builtin_amdgcn_permlane32_swap(__float_as_uint(m),__float_as_uint(m),false,false);
  return max2f(__uint_as_float(rr[0]),__uint_as_float(rr[1]));
}
__device__ __forceinline__ void pv(f32x16*o,int vb,bf16x8 pa0,bf16x8 pa1,bf16x8 pa2,bf16x8 pa3){
  #pragma unroll
  for(int d0=0;d0<2;++d0){s16x4 lo[4],hi[4];
    #pragma unroll
    for(int ks=0;ks<4;++ks){
      asm volatile("ds_read_b64_tr_b16 %0,%1 offset:%c2":"=&v"(lo[ks]):"v"(vb),"i"(d0*4096+ks*1024):"memory");
      asm volatile("ds_read_b64_tr_b16 %0,%1 offset:%c2":"=&v"(hi[ks]):"v"(vb),"i"(d0*4096+ks*1024+512):"memory");}
    asm volatile("s_waitcnt lgkmcnt(0)":::"memory");SBAR();
    #define PK(k) (bf16x8){lo[k][0],lo[k][1],lo[k][2],lo[k][3],hi[k][0],hi[k][1],hi[k][2],hi[k][3]}
    o[d0]=__builtin_amdgcn_mfma_f32_32x32x16_bf16(pa0,PK(0),o[d0],0,0,0);
    o[d0]=__builtin_amdgcn_mfma_f32_32x32x16_bf16(pa1,PK(1),o[d0],0,0,0);
    o[d0]=__builtin_amdgcn_mfma_f32_32x32x16_bf16(pa2,PK(2),o[d0],0,0,0);
    o[d0]=__builtin_amdgcn_mfma_f32_32x32x16_bf16(pa3,PK(3),o[d0],0,0,0);
    #undef PK
  }
}

#ifndef ATTN_STORE16
#define ATTN_STORE16(p,v) (*(u32x4*)(p)=(v))
#endif
template<int THRL> __device__ __forceinline__ void attn_unit(const bf16*Qu,const bf16*__restrict__ Kh,const bf16*__restrict__ Vh,const int NT,bf16*Ou,const bf16*Gu,char*shm){
  int tid_=threadIdx.x; asm volatile("":"+v"(tid_)); const int tid=tid_,lane=tid&63,r32=lane&31,hi=lane>>5; const int wid=__builtin_amdgcn_readfirstlane(tid>>6);
  const bf16*Qw=Qu+(long)(wid*QBLK)*QP;
  const unsigned lds0=(unsigned)(uintptr_t)shm;
  float*wsf=(float*)(shm+LDS_WS)+wid*64;
  const bf16*ksrc=Kh+(long)lane*KVP+wid*8;
  const bf16*vsrc=Vh+(long)(16*(wid&3)+(lane>>2))*KVP+(wid>>2)*32+(lane&3)*8;
  const unsigned kdst=lds0+LDS_K+wid*1024, vdst=lds0+LDS_V+wid*1024;
  #define DMA_K(t,slot) glds16(ksrc+(long)(t)*KVBLK*KVP,(unsigned)__builtin_amdgcn_readfirstlane(kdst+(slot)))
  #define DMA_V(t,slot) glds16(vsrc+(long)(t)*KVBLK*KVP,(unsigned)__builtin_amdgcn_readfirstlane(vdst+(slot)))
  const int vb0=(int)(lds0+LDS_V)+((lane>>4)&1)*32+(lane&3)*8+(4*hi+((lane&15)>>2))*64;
  const char*Kbase=shm+LDS_K; bf16x8 kf[8];
  const lds_cptr shm3=(lds_cptr)shm; const lds_cptr kp0=shm3+LDS_K+hi*1024+r32*16; const lds_cptr vp0=shm3+LDS_V+((lane>>4)&1)*32+(lane&3)*8+(4*hi+((lane&15)>>2))*64;
  DMA_K(0,0);DMA_V(0,0);DMA_K(1,SLOTB);
  bf16x8 qr[4];
  #pragma unroll
  for(int d0=0;d0<4;++d0)qr[d0]=*reinterpret_cast<const bf16x8*>(&Qw[(long)r32*QP+d0*16+hi*8]);
  float mhat=0.f,l_reg=0.f;f32x16 o[2];o[0]=f32x16{};o[1]=f32x16{};f32x16 negm=f32x16{};asm volatile("":"+v"(negm));
  #define CMASK(P0,P1,t) do{}while(0)
  bool resc=false;
  #define START(P0,P1) do{ const float rm=rowmax(P0,P1); resc=false; \
    { const float dl=rm; mhat=fadd_s(mhat,dl); \
      _Pragma("unroll") for(int r=0;r<16;++r){P0[r]=fsub_s(P0[r],dl);P1[r]=fsub_s(P1[r],dl);} \
      _Pragma("unroll") for(int r=0;r<16;++r)negm[r]=-mhat; asm volatile("":"+v"(negm)); } \
    _Pragma("unroll") for(int r=0;r<16;++r)P0[r]=__builtin_amdgcn_exp2f(P0[r]); }while(0)
  #define RESC() do{ if(resc){ asm volatile("s_waitcnt lgkmcnt(0)":::"memory"); \
      _Pragma("unroll") for(int d_=0;d_<2;++d_) _Pragma("unroll") for(int r=0;r<16;++r)o[d_][r]*=wsf[crow(r,hi)]; } }while(0)
  f32x16 pA0,pA1,pB0,pB1;
  int sl_prev=0,sl_cur=0,sl_next=SLOTB;
  #define ROT() do{sl_prev=sl_cur;sl_cur=sl_next;sl_next=(sl_next==(NSLOT-1)*SLOTB)?0:sl_next+SLOTB;}while(0)
  DMA_K(2,2*SLOTB);
  WAIT_BAR(3);
  qkt(pA0,pA1,Kbase,qr,negm,r32,hi);asm volatile("s_nop 15\n\ts_nop 7":"+v"(pA0),"+v"(pA1));CMASK(pA0,pA1,0);
  START(pA0,pA1);
  _Pragma("unroll") for(int r=0;r<16;++r)pA1[r]=__builtin_amdgcn_exp2f(pA1[r]);
  WAIT_BAR(0);
  DMA_K(3,0);DMA_V(1,SLOTB);
  ROT();
  kload8(kf,kp0+sl_cur);
  WAIT_BAR(2);
  s16x4 vlo[8],vhi[8]; u32x4 pw0,pw1,pw2,pw3;
  #define PKW(P,B) cvtpk_s(P[B],P[B+1])
  #define PAF(k) __builtin_bit_cast(bf16x8,pw##k)
  #define VFR(i) (bf16x8){vlo[i][0],vlo[i][1],vlo[i][2],vlo[i][3],vhi[i][0],vhi[i][1],vhi[i][2],vhi[i][3]}
  #define PIN(x) asm volatile("":"+v"(x))
  #define MX3(a,b,c) __builtin_fmaxf(__builtin_fmaxf((a),(b)),(c))
  #define GAPA(MF,A0,A1,A2,A3,W0,W1,PW) do{ MF; sacc+=A0; sacc+=A1; sacc+=A2; sacc+=A3; PIN(sacc); W0; W1; PIN(PW); SBAR(); }while(0)
  #define EX(v) __builtin_amdgcn_exp2f(v)
  #define GAPB(MF,X,B) do{ MF; X[B]=EX(X[B]); X[B+1]=EX(X[B+1]); X[B+2]=EX(X[B+2]); X[B+3]=EX(X[B+3]); PIN(X); SBAR(); }while(0)
  #define VRD(i) do{ vlo[i]=vtr(vp_+(((i)>>2)*4096+((i)&3)*1024)); vhi[i]=vtr(vp_+(((i)>>2)*4096+((i)&3)*1024+512)); }while(0)
  #define KRD(G,j) do{ if(G){ kload2(kf,kp0+sl_next,j); SBAR(); } }while(0)
  #define STEP(C0,C1,P0,P1,t,GK,GV,GL) do{ SBAR(); \
    const lds_cptr vp_=vp0+sl_prev; \
    VRD(0); SBAR(); float sacc=(P0[0]+P0[1]); \
    GAPA(C0=__builtin_amdgcn_mfma_f32_32x32x16_bf16(kf[0],qr[0],negm,0,0,0), P0[2],P0[3],P0[4],P0[5],     pw0[0]=PKW(P0,0), pw0[1]=PKW(P0,2), pw0); \
    VRD(4); SBAR(); GAPA(C1=__builtin_amdgcn_mfma_f32_32x32x16_bf16(kf[1],qr[0],negm,0,0,0), P0[6],P0[7],P0[8],P0[9],     pw0[2]=PKW(P0,4), pw0[3]=PKW(P0,6), pw0); \
    VRD(1); SBAR(); GAPA(C0=__builtin_amdgcn_mfma_f32_32x32x16_bf16(kf[2],qr[1],C0,0,0,0),   P0[10],P0[11],P0[12],P0[13], pw1[0]=PKW(P0,8), pw1[1]=PKW(P0,10), pw1); \
    VRD(5); SBAR(); GAPA(C1=__builtin_amdgcn_mfma_f32_32x32x16_bf16(kf[3],qr[1],C1,0,0,0),   P0[14],P0[15],P1[0],P1[1],   pw1[2]=PKW(P0,12),pw1[3]=PKW(P0,14), pw1); \
    VRD(2); SBAR(); GAPA(C0=__builtin_amdgcn_mfma_f32_32x32x16_bf16(kf[4],qr[2],C0,0,0,0),   P1[2],P1[3],P1[4],P1[5],     pw2[0]=PKW(P1,0), pw2[1]=PKW(P1,2), pw2); \
    VRD(6); SBAR(); GAPA(C1=__builtin_amdgcn_mfma_f32_32x32x16_bf16(kf[5],qr[2],C1,0,0,0),   P1[6],P1[7],P1[8],P1[9],     pw2[2]=PKW(P1,4), pw2[3]=PKW(P1,6), pw2); \
    VRD(3); SBAR(); GAPA(C0=__builtin_amdgcn_mfma_f32_32x32x16_bf16(kf[6],qr[3],C0,0,0,0),   P1[10],P1[11],P1[12],P1[13], pw3[0]=PKW(P1,8), pw3[1]=PKW(P1,10), pw3); \
    VRD(7); SBAR(); GAPA(C1=__builtin_amdgcn_mfma_f32_32x32x16_bf16(kf[7],qr[3],C1,0,0,0),   P1[14],P1[15],0.f,0.f,       pw3[2]=PKW(P1,12),pw3[3]=PKW(P1,14), pw3); \
    l_reg+=sacc; \
    if(GK){DMA_K((t)+3,sl_cur);} if(GV){DMA_V((t)+1,sl_next);} \
    CMASK(C0,C1,t); \
    { float a=MX3(C0[0],C0[1],C1[0]),b=MX3(C0[2],C0[3],C1[1]); a=MX3(a,C1[2],C1[3]); \
      _Pragma("unroll") for(int r=4;r<16;r+=4){a=MX3(a,C0[r],C0[r+1]);b=MX3(b,C0[r+2],C0[r+3]);a=MX3(a,C1[r],C1[r+1]);b=MX3(b,C1[r+2],C1[r+3]);} \
      float rm=__builtin_fmaxf(a,b); { auto rr=__builtin_amdgcn_permlane32_swap(__float_as_uint(rm),__float_as_uint(rm),false,false); rm=__builtin_fmaxf(__uint_as_float(rr[0]),__uint_as_float(rr[1])); } \
      resc=false; \
      if(__builtin_expect(__any(rm>(float)THRL),0)){ const float dl=__builtin_fmaxf(rm,0.f); mhat+=dl; \
        _Pragma("unroll") for(int r=0;r<16;++r){C0[r]-=dl;C1[r]-=dl;} \
        _Pragma("unroll") for(int r=0;r<16;++r)negm[r]=-mhat; asm volatile("":"+v"(negm)); \
        const float f=__builtin_amdgcn_exp2f(-dl); l_reg*=f; if(hi==0)wsf[r32]=f; resc=true; } } \
    SBAR(); \
    GAPB(o[0]=__builtin_amdgcn_mfma_f32_32x32x16_bf16(PAF(0),VFR(0),o[0],0,0,0), C0,0); \
    GAPB(o[1]=__builtin_amdgcn_mfma_f32_32x32x16_bf16(PAF(0),VFR(4),o[1],0,0,0), C0,4); \
    KRD(GL,0); GAPB(o[0]=__builtin_amdgcn_mfma_f32_32x32x16_bf16(PAF(1),VFR(1),o[0],0,0,0), C0,8); \
    KRD(GL,1); GAPB(o[1]=__builtin_amdgcn_mfma_f32_32x32x16_bf16(PAF(1),VFR(5),o[1],0,0,0), C0,12); \
    KRD(GL,2); GAPB(o[0]=__builtin_amdgcn_mfma_f32_32x32x16_bf16(PAF(2),VFR(2),o[0],0,0,0), C1,0); \
    KRD(GL,3); GAPB(o[1]=__builtin_amdgcn_mfma_f32_32x32x16_bf16(PAF(2),VFR(6),o[1],0,0,0), C1,4); \
    GAPB(o[0]=__builtin_amdgcn_mfma_f32_32x32x16_bf16(PAF(3),VFR(3),o[0],0,0,0), C1,8); \
    GAPB(o[1]=__builtin_amdgcn_mfma_f32_32x32x16_bf16(PAF(3),VFR(7),o[1],0,0,0), C1,12); \
    }while(0)
  int t=1;
  #undef CMASK
  #define CMASK(P0,P1,t) do{}while(0)
  for(;t+5<NT;t+=2){
    STEP(pB0,pB1,pA0,pA1,t,true,true,true);     WAIT_BAR(2); RESC(); ROT();
    STEP(pA0,pA1,pB0,pB1,t+1,true,true,true);   WAIT_BAR(2); RESC(); ROT();
  }
  #undef CMASK
  #define CMASK(P0,P1,t) do{}while(0)
  #define ENDW(tt) do{ if((tt)+3<NT){WAIT_BAR(2);} else if((tt)+2<NT){WAIT_BAR(1);} else {WAIT_BAR(0);} }while(0)
  for(;t+1<NT;t+=2){
    STEP(pB0,pB1,pA0,pA1,t,(t+3<NT),(t+1<NT),(t+1<NT));       ENDW(t);   RESC(); ROT();
    STEP(pA0,pA1,pB0,pB1,t+1,(t+4<NT),(t+2<NT),(t+2<NT));     ENDW(t+1); RESC(); ROT();
  }
  STEP(pB0,pB1,pA0,pA1,NT-1,false,false,false); RESC();
  { float sacc=pB0[0]+pB0[1]; _Pragma("unroll") for(int r=2;r<16;++r)sacc+=pB0[r]; _Pragma("unroll") for(int r=0;r<16;++r)sacc+=pB1[r]; l_reg+=sacc;
    pw0=(u32x4){PKW(pB0,0),PKW(pB0,2),PKW(pB0,4),PKW(pB0,6)};pw1=(u32x4){PKW(pB0,8),PKW(pB0,10),PKW(pB0,12),PKW(pB0,14)};pw2=(u32x4){PKW(pB1,0),PKW(pB1,2),PKW(pB1,4),PKW(pB1,6)};pw3=(u32x4){PKW(pB1,8),PKW(pB1,10),PKW(pB1,12),PKW(pB1,14)};
    SBAR(); pv(o,vb0+sl_cur,PAF(0),PAF(1),PAF(2),PAF(3)); }
  #undef PKW
  #undef PAF
  #undef VFR
  #undef PIN
  #undef MX3
  #undef GAPA
  #undef GAPB
  #undef EX
  #undef VRD
  #undef KRD
  #undef STEP
  #undef ENDW
  {auto rr=__builtin_amdgcn_permlane32_swap(__float_as_uint(l_reg),__float_as_uint(l_reg),false,false);l_reg=__uint_as_float(rr[0])+__uint_as_float(rr[1]);}
  if(hi==0)wsf[32+r32]=l_reg;asm volatile("s_waitcnt lgkmcnt(0)":::"memory");
  float rli[16];
  #pragma unroll
  for(int r=0;r<16;++r)rli[r]=__builtin_amdgcn_rcpf(wsf[32+crow(r,hi)]);
  bf16*Ow=Ou+(long)(wid*QBLK)*QP; const bf16*Gw=Gu+(long)(wid*QBLK)*QP;
  { bf16*stg=(bf16*)(shm+LDS_OST)+wid*2048;
    #pragma unroll
    for(int r=0;r<16;++r){const int orow=crow(r,hi);
      #pragma unroll
      for(int d0=0;d0<2;++d0)stg[orow*64+d0*32+r32]=__float2bfloat16(o[d0][r]*rli[r]);}
    asm volatile("s_waitcnt lgkmcnt(0)":::"memory");
    #pragma unroll
    for(int i=0;i<4;++i){const int row=i*8+(lane>>3),ch=lane&7; const u32x4 v=*(const u32x4*)(stg+row*64+ch*8); const u32x4 gg=*(const u32x4*)(Gw+(long)row*QP+ch*8); u32x4 w_;
      _Pragma("unroll") for(int e_=0;e_<4;++e_){ const float a0=__uint_as_float(v[e_]<<16)*__uint_as_float(gg[e_]<<16), a1=__uint_as_float(v[e_]&0xffff0000u)*__uint_as_float(gg[e_]&0xffff0000u); w_[e_]=cvtpk_s(a0,a1); }
      ATTN_STORE16(Ow+(long)row*QP+ch*8,w_);} }
  asm volatile("s_waitcnt lgkmcnt(0)\n\ts_barrier":::"memory");
  #undef DMA_K
  #undef DMA_V
  #undef CMASK
  #undef START
  #undef RESC
  #undef ROT
}
constexpr int ATTN_LDS_BYTES=LDS_BYTES;
#undef SBAR
#undef WAIT_BAR
}
constexpr int NWAVES = 8;
constexpr int N_LAUNCHES = MK_N_LAUNCHES;
constexpr int NPHASE = 10;
constexpr int DM = 1024, MTOK = 12288, MP = 8192, NB_P = 32, L_P = 256, NB_S = 4, L_S = 1024, PAST = 256;
constexpr int N1 = 2560, N3 = 5120, KVROWS = MP + NB_S * (PAST + L_S);
constexpr float LN_EPS = 1e-5f;
constexpr size_t OUT_Y = 0, OUT_K = (size_t)MTOK * DM, OUT_V = OUT_K + (size_t)MP * 256, OUT_S = OUT_V + (size_t)MP * 256, OUT_END = OUT_S + (size_t)NB_P * 2 * 8 * 128 * 128;
constexpr size_t MiB = 1u << 20;
constexpr size_t WS_CTL = 0, CTL_ZERO_BYTES = 1 * MiB;
constexpr size_t WS_MOD = 512 * 1024;
constexpr size_t WS_ROPE = 1 * MiB;
constexpr size_t WS_W1 = 2 * MiB, WS_W2 = 7 * MiB, WS_W3 = 9 * MiB, WS_W4 = 19 * MiB;
constexpr size_t WS_A = 22 * MiB;
constexpr size_t WS_B = 46 * MiB;
constexpr size_t WS_C = 70 * MiB;
constexpr size_t WS_D = 94 * MiB;
constexpr size_t WS_KALL = 118 * MiB, WS_VALL = 125 * MiB;
constexpr size_t WS_LF = 132 * MiB;
constexpr size_t WS_OF = 180 * MiB;
constexpr size_t WS_END = 204 * MiB;
static_assert((size_t)KVROWS * 256 * 2 <= 7 * MiB && (size_t)MTOK * DM * 2 == 24 * MiB, "ws map");
constexpr int CW_BAR = 4096, CW_GLA = 16384;

constexpr int RING_OFF = 0, RING_BYTES = 131072;
constexpr int LDSCTL_OFF = 139264, MISC_OFF = LDSCTL_OFF + 320;
constexpr int LDS_BYTES = 147456;
#define GAS __attribute__((address_space(1)))
#define LAS __attribute__((address_space(3)))
typedef unsigned short bf16;
typedef unsigned v4u __attribute__((ext_vector_type(4)));
typedef float f32x4 __attribute__((ext_vector_type(4)));
typedef short bf16x8 __attribute__((ext_vector_type(8)));
typedef GAS unsigned gu32;
typedef GAS unsigned long long gu64;
#define RLX_AGENT __ATOMIC_RELAXED, __HIP_MEMORY_SCOPE_AGENT
#define LDS_WAIT() asm volatile("s_waitcnt lgkmcnt(0)" ::: "memory")
#define VM_WAIT() asm volatile("s_waitcnt vmcnt(0)" ::: "memory")
__device__ __forceinline__ unsigned long long rt() { return __builtin_amdgcn_s_memrealtime(); }
__device__ __forceinline__ unsigned f2bf(float f) { unsigned u = __builtin_bit_cast(unsigned, f); return (u + 0x7fffu + ((u >> 16) & 1u)) >> 16; }
__device__ __forceinline__ unsigned pk2(float lo, float hi) { return f2bf(lo) | (f2bf(hi) << 16); }

#define XB_TMO      128
#define XB_XCNT(j)  (256  + 64 * (j))
#define XB_XSUB(j)  (1280 + 64 * (j))
#define XB_XGEN(j)  (2304 + 64 * (j))
#define XB_TOP      3328
#define XB_TOPGEN   3392
#define XCD_BAR_WORDS 3456
#define XB_SPIN_CAP (1u << 18)

__device__ __forceinline__ unsigned xb_ld(unsigned* p)              { return __hip_atomic_load(p, __ATOMIC_RELAXED, __HIP_MEMORY_SCOPE_AGENT); }
__device__ __forceinline__ unsigned xb_add(unsigned* p, unsigned v) { return __hip_atomic_fetch_add(p, v, __ATOMIC_RELAXED, __HIP_MEMORY_SCOPE_AGENT); }
__device__ __forceinline__ unsigned xb_xcc_id() { return (unsigned)__builtin_amdgcn_s_getreg((3 << 11) | 20) & 0xFu; }
#define XB_SPIN(cond, bar) do { unsigned _sp = 0; while (cond) { __builtin_amdgcn_s_sleep(1); \
    if ((++_sp & 255u) == 0u) { if (xb_ld(&(bar)[XB_TMO])) break; if (_sp > XB_SPIN_CAP) { atomicAdd(&(bar)[XB_TMO], 1u); break; } } } } while (0)

struct XcdBarrier {
    unsigned* bar; unsigned x;
    volatile LAS unsigned* st;
};

__device__ __forceinline__ XcdBarrier xcd_barrier_post(unsigned* bar, volatile LAS unsigned* st) {
    XcdBarrier b; b.bar = bar; b.x = xb_xcc_id(); b.st = st;
    if (threadIdx.x == 0) (void)xb_add(&bar[XB_XCNT(b.x)], 1u);
    return b;
}
__device__ __forceinline__ void xcd_barrier_complete(unsigned* bar, unsigned x, unsigned& nloc, unsigned& nx) {
    const unsigned G = gridDim.x * gridDim.y * gridDim.z;
    unsigned sum, cnt, mine, sp = 0u;
    for (;;) {
        sum = 0u; cnt = 0u; mine = 0u;
#pragma unroll
        for (unsigned j = 0; j < 16; ++j) { const unsigned c = xb_ld(&bar[XB_XCNT(j)]); sum += c; cnt += (c > 0u) ? 1u : 0u; mine = (j == x) ? c : mine; }
        if (sum == G) break;
        __builtin_amdgcn_s_sleep(1);
        if ((++sp & 255u) == 0u) { if (xb_ld(&bar[XB_TMO])) break; if (sp > XB_SPIN_CAP) { atomicAdd(&bar[XB_TMO], 1u); break; } }
    }
    nloc = mine > 0u ? mine : 1u; nx = cnt > 0u ? cnt : 1u;
}

__device__ __forceinline__ void xcd_barrier(const XcdBarrier& b) {
    asm volatile("s_waitcnt vmcnt(0)" ::: "memory");
    __syncthreads();
    if (threadIdx.x == 0) {
        unsigned* bar = b.bar;
        __builtin_amdgcn_s_waitcnt(0);
        unsigned nloc = b.st[0], nx = b.st[1];
        if (nloc == 0u) { xcd_barrier_complete(bar, b.x, nloc, nx); b.st[0] = nloc; b.st[1] = nx; }
        const unsigned old = xb_add(&bar[XB_XSUB(b.x)], 1u);
        const unsigned gen = old / nloc;
        if (old + 1u == (gen + 1u) * nloc) {
            __builtin_amdgcn_fence(__ATOMIC_RELEASE, "agent");
            asm volatile("s_waitcnt vmcnt(0)" ::: "memory");
            const unsigned og = xb_add(&bar[XB_TOP], 1u);
            const unsigned tg = og / nx;
            if (og + 1u == (tg + 1u) * nx) xb_add(&bar[XB_TOPGEN], 1u);
            else XB_SPIN(xb_ld(&bar[XB_TOPGEN]) == tg, bar);
            __builtin_amdgcn_fence(__ATOMIC_ACQUIRE, "agent");
            xb_add(&bar[XB_XGEN(b.x)], 1u);
            asm volatile("s_waitcnt vmcnt(0)" ::: "memory");
        } else {
            XB_SPIN(xb_ld(&bar[XB_XGEN(b.x)]) == gen, bar);
            __builtin_amdgcn_fence(__ATOMIC_ACQUIRE, "agent");
            asm volatile("s_waitcnt vmcnt(0)" ::: "memory");
        }
    }
    __syncthreads();
}
struct Frame {
    LAS unsigned char* lds;
    volatile LAS unsigned* MISC;
    gu32* ctl;
    int tid, lane, wave, vcu, G;
};
__device__ __forceinline__ float bf2f_lo(unsigned u) { return __uint_as_float(u << 16); }
__device__ __forceinline__ float bf2f_hi(unsigned u) { return __uint_as_float(u & 0xffff0000u); }
__device__ __forceinline__ float wave_sum(float v) {
#pragma unroll
    for (int o = 1; o < 64; o <<= 1) v += __shfl_xor(v, o);
    return v;
}
__device__ __forceinline__ void sincos_cw(float x, float& sn, float& cs) {
    const float kf = rintf(x * 0.63661977236758134f); const int k = (int)kf;
    float r = fmaf(-kf, 1.5707962513e+00f, x); r = fmaf(-kf, 7.5497894159e-08f, r);
    const float r2 = r * r;
    const float s = r + r * r2 * (-1.6666666667e-01f + r2 * (8.3333333333e-03f + r2 * (-1.9841269841e-04f + r2 * 2.7557319224e-06f)));
    const float c = 1.0f + r2 * (-0.5f + r2 * (4.1666666667e-02f + r2 * (-1.3888888889e-03f + r2 * (2.4801587302e-05f + r2 * -2.7557319224e-07f))));
    switch (k & 3) { case 0: sn = s; cs = c; break; case 1: sn = c; cs = -s; break; case 2: sn = -s; cs = -c; break; default: sn = -c; cs = s; break; }
}
__device__ __forceinline__ int slot_of(int mode, int n) {
    if (mode == 0) return n;
    const int t = n & ~255, L = n & 255;
    if (mode == 1 && (n >> 8) <= 4) { const int wc = L >> 6, bj = (L >> 5) & 1; return t + 128 * bj + 32 * wc + (L & 31); }
    const int hi = L & ~31, r5 = L & 31, fq = r5 >> 3, nn = (r5 >> 2) & 1, e = r5 & 3; return t + hi + 16 * nn + 4 * fq + e;
}
__device__ __forceinline__ void p0_transpose_item(const float* W, int K, int N, bf16* WT, int mode, LAS float* scr, int item, int lane) {
    const int nblk = N / 32, kb = item / nblk, nb = item % nblk, k0 = 64 * kb, n0 = 32 * nb;
#pragma unroll 8
    for (int i = 0; i < 32; ++i) { const int kk = 2 * i + (lane >> 5); scr[kk * 33 + (lane & 31)] = W[(size_t)(k0 + kk) * N + n0 + (lane & 31)]; }
    LDS_WAIT(); asm volatile("" ::: "memory");
    const int c = lane & 7;
#pragma unroll
    for (int j = 0; j < 4; ++j) { const int n = (lane >> 3) + 8 * j; const LAS float* s = scr + (8 * c) * 33 + n;
        v4u o; o.x = pk2(s[0 * 33], s[1 * 33]); o.y = pk2(s[2 * 33], s[3 * 33]); o.z = pk2(s[4 * 33], s[5 * 33]); o.w = pk2(s[6 * 33], s[7 * 33]);
        *(GAS v4u*)(WT + (size_t)slot_of(mode, n0 + n) * K + k0 + 8 * c) = o; }
    LDS_WAIT(); asm volatile("" ::: "memory");
}
struct Ptrs {
    const float *x_prompt, *x_sample, *cache_k, *cache_v, *state_rec, *c, *c_ctx, *ada_w, *ada_b, *attn_w_in, *attn_q_gain, *attn_k_gain, *attn_w_out,
                *rec_w_in, *rec_lb, *rec_norm_gain, *rec_w_out, *ln_gain, *ln_bias;
    float* out; unsigned char* ws;
};
__device__ __forceinline__ void p0_adaln_item(const Ptrs& P, float* mod, LAS float* scr, int item, int lane) {
    const int kc = item & 7, cbk = (item >> 3) % 48, l = item / (8 * 48), k0 = kc * 128, c0 = cbk * 64;
#pragma unroll
    for (int j = 0; j < 5; ++j)
#pragma unroll
        for (int t = 0; t < 2; ++t) { const int kk = lane + 64 * t; const float cv = (j == 0) ? P.c_ctx[k0 + kk] : P.c[(j - 1) * 1024 + k0 + kk]; scr[j * 128 + kk] = cv / (1.f + __expf(-cv)); }
    LDS_WAIT(); asm volatile("" ::: "memory");
    float a0 = 0.f, a1 = 0.f, a2 = 0.f, a3 = 0.f, a4 = 0.f;
    const float* w = P.ada_w + (size_t)l * 1024 * 3072 + (size_t)k0 * 3072 + c0 + lane;
#pragma unroll 8
    for (int kk = 0; kk < 128; ++kk) { const float wv = w[(size_t)kk * 3072];
        a0 += scr[kk] * wv; a1 += scr[128 + kk] * wv; a2 += scr[256 + kk] * wv; a3 += scr[384 + kk] * wv; a4 += scr[512 + kk] * wv; }
    if (kc == 0) { const float b = P.ada_b[l * 3072 + c0 + lane]; a0 += b; a1 += b; a2 += b; a3 += b; a4 += b; }
    float* mo = mod + (size_t)l * 5 * 3072 + c0 + lane;
    atomicAdd(mo, a0); atomicAdd(mo + 3072, a1); atomicAdd(mo + 2 * 3072, a2); atomicAdd(mo + 3 * 3072, a3); atomicAdd(mo + 4 * 3072, a4);
    LDS_WAIT(); asm volatile("" ::: "memory");
}
__device__ __forceinline__ void p0_prologue(Frame& F, const Ptrs& P, const bool with_adaln) {
    int lane_ = threadIdx.x & 63; asm volatile("" : "+v"(lane_));
    LAS float* scr = (LAS float*)(F.lds + RING_OFF + F.wave * 16384);
    const int gw = F.vcu * NWAVES + F.wave, NGW = F.G * NWAVES;
    bf16* W1 = (bf16*)(P.ws + WS_W1); bf16* W2 = (bf16*)(P.ws + WS_W2); bf16* W3 = (bf16*)(P.ws + WS_W3); bf16* W4 = (bf16*)(P.ws + WS_W4);
    constexpr int I_1 = (DM / 64) * (N1 / 32), I_2 = (DM / 64) * (DM / 32), I_3 = (DM / 64) * (N3 / 32), I_4 = I_2, I_A = 2 * 48 * 8;
    constexpr int NITEMS = I_A + I_1 + I_2 + I_3 + I_4;
    for (int it = gw; it < NITEMS; it += NGW) {
        int r = it;
        if (r < I_A) { if (with_adaln) p0_adaln_item(P, (float*)(P.ws + WS_MOD), scr, r, lane_); continue; } r -= I_A;
        if (r < I_1) { p0_transpose_item(P.attn_w_in, DM, N1, W1, 1, scr, r, lane_); continue; } r -= I_1;
        if (r < I_2) { p0_transpose_item(P.attn_w_out, DM, DM, W2, 0, scr, r, lane_); continue; } r -= I_2;
        if (r < I_3) { p0_transpose_item(P.rec_w_in, DM, N3, W3, 2, scr, r, lane_); continue; } r -= I_3;
        p0_transpose_item(P.rec_w_out, DM, DM, W4, 0, scr, r, lane_);
    }
    const int gt = gw * 64 + lane_, NGT = NGW * 64;
    if (gt < 1024) { const int pos = gt >> 4, i = gt & 15; const float inv = exp2f(-(float)i * (13.287712379549449f / 16.0f)); const float ang = (float)pos * inv;
        float* tab = (float*)(P.ws + WS_ROPE); float sn, cs; sincos_cw(ang, sn, cs); tab[pos * 32 + i] = cs; tab[pos * 32 + 16 + i] = sn; }
    bf16* Kall = (bf16*)(P.ws + WS_KALL); bf16* Vall = (bf16*)(P.ws + WS_VALL);
    for (int it = gt; it < 2 * 32768; it += NGT) { const int which = it >> 15, i8 = it & 32767, b = i8 >> 13, t = (i8 >> 5) & 255, c8 = i8 & 31;
        const float* src = (which ? P.cache_v : P.cache_k) + ((size_t)(b * 256 + t) * 256 + c8 * 8);
        const f32x4 x0 = *(const GAS f32x4*)src, x1 = *(const GAS f32x4*)(src + 4);
        v4u o; o.x = pk2(x0.x, x0.y); o.y = pk2(x0.z, x0.w); o.z = pk2(x1.x, x1.y); o.w = pk2(x1.z, x1.w);
        *(GAS v4u*)((which ? Vall : Kall) + ((size_t)(MP + b * 1280 + t) * 256 + c8 * 8)) = o; }
}
__device__ __forceinline__ void p1_modulate(Frame& F, const Ptrs& P) {
    int lane_ = threadIdx.x & 63; asm volatile("" : "+v"(lane_));
    const int gw = F.vcu * NWAVES + F.wave, NGW = F.G * NWAVES;
    const float* mod = (const float*)(P.ws + WS_MOD); bf16* H = (bf16*)(P.ws + WS_A);
    for (int m = gw; m < MTOK; m += NGW) {
        const int cond = m < MP ? 0 : 1 + ((m - MP) >> 10);
        const float* xr = m < MP ? P.x_prompt + (size_t)m * DM : P.x_sample + (size_t)(m - MP) * DM;
        const float* sh = mod + (size_t)cond * 3072, *sc = sh + 1024;
        GAS unsigned long long* o8 = (GAS unsigned long long*)(H + (size_t)m * DM) + lane_;
#pragma unroll
        for (int j = 0; j < 4; ++j) { const int c = 4 * lane_ + 256 * j; const f32x4 x = *(const GAS f32x4*)(xr + c), s = *(const GAS f32x4*)(sc + c), t = *(const GAS f32x4*)(sh + c);
            const f32x4 h = x * (s + 1.0f) + t; o8[64 * j] = (unsigned long long)pk2(h.x, h.y) | ((unsigned long long)pk2(h.z, h.w) << 32); }
    }
}
template <bool WITH_H>
__device__ __forceinline__ void p_layernorm(Frame& F, const Ptrs& P, float* Y, const float* lng, const float* lnb, const float* modl) {
    int lane_ = threadIdx.x & 63; asm volatile("" : "+v"(lane_));
    const int gw = F.vcu * NWAVES + F.wave, NGW = F.G * NWAVES; bf16* H = (bf16*)(P.ws + WS_A);
    for (int m = gw; m < MTOK; m += NGW) {
        GAS f32x4* yr = (GAS f32x4*)(Y + (size_t)m * DM) + lane_;
        f32x4 v[4]; float s = 0.f;
#pragma unroll
        for (int j = 0; j < 4; ++j) { v[j] = yr[64 * j]; s += (v[j].x + v[j].y) + (v[j].z + v[j].w); }
        const float mean = wave_sum(s) * (1.f / DM); float s2 = 0.f;
#pragma unroll
        for (int j = 0; j < 4; ++j) { v[j] = v[j] - mean; s2 += (v[j].x * v[j].x + v[j].y * v[j].y) + (v[j].z * v[j].z + v[j].w * v[j].w); }
        const float rstd = rsqrtf(wave_sum(s2) * (1.f / DM) + LN_EPS);
        const int cond = m < MP ? 0 : 1 + ((m - MP) >> 10);
        GAS unsigned long long* o8 = (GAS unsigned long long*)(H + (size_t)m * DM) + lane_;
#pragma unroll
        for (int j = 0; j < 4; ++j) { const int c = 4 * lane_ + 256 * j; const f32x4 g = *(const GAS f32x4*)(lng + c), b = *(const GAS f32x4*)(lnb + c);
            const f32x4 x1 = v[j] * rstd * g + b; yr[64 * j] = x1;
            if (WITH_H) { const f32x4 t = *(const GAS f32x4*)(modl + (size_t)cond * 3072 + c), sc = *(const GAS f32x4*)(modl + (size_t)cond * 3072 + 1024 + c);
                const f32x4 h = x1 * (sc + 1.0f) + t; o8[64 * j] = (unsigned long long)pk2(h.x, h.y) | ((unsigned long long)pk2(h.z, h.w) << 32); } }
    }
}
namespace gla {
typedef short bf16x8 __attribute__((ext_vector_type(8)));
typedef float f32x4 __attribute__((ext_vector_type(4)));
typedef float f32x2 __attribute__((ext_vector_type(2)));
typedef unsigned u32x2 __attribute__((ext_vector_type(2)));
typedef unsigned u32x4 __attribute__((ext_vector_type(4)));
typedef _Float16 f16x2 __attribute__((ext_vector_type(2)));
#define GLAS __attribute__((address_space(3)))
constexpr int QT_OFF = 0, QT_STR = 272, KT_OFF = 17408, KH_OFF = 34816, KH_STR = 144, VT_OFF = KH_OFF + 128 * KH_STR, AS_OFF = VT_OFF + 128 * KH_STR, AS_STR = 144,
              TOT_OFF = AS_OFF + 64 * AS_STR, EBR_OFF = TOT_OFF + 4096, EBL_OFF = EBR_OFF + 512, RS_OFF = EBL_OFF + 512, RAW_OFF = RS_OFF + 2048  , GLA_LDS_BYTES = RAW_OFF + 3 * 16384;
static_assert(KT_OFF == 64 * QT_STR && KH_OFF == 2 * 64 * QT_STR && GLA_LDS_BYTES <= 139264, "gla lds map");
struct GlaT { const unsigned short *QR, *VR, *GR; const _Float16* Z; unsigned short *OF, *GO; const float* ngain; const float* rlb; };
__device__ __forceinline__ void glds16(const void* gsrc, unsigned lds_dst) { unsigned keep;
    asm volatile("s_mov_b32 %0, m0\n\ts_mov_b32 m0, %2\n\ts_nop 0\n\tglobal_load_lds_dwordx4 %1, off\n\ts_mov_b32 m0, %0" : "=&s"(keep) : "v"(gsrc), "s"(lds_dst) : "memory"); }
__device__ __forceinline__ unsigned pkbf(float lo, float hi) { typedef float f2 __attribute__((ext_vector_type(2))); typedef __bf16 b2 __attribute__((ext_vector_type(2))); f2 v = {lo, hi}; b2 b = __builtin_convertvector(v, b2); return __builtin_bit_cast(unsigned, b); }
__device__ __forceinline__ float lo2f(unsigned u) { return __uint_as_float(u << 16); }
__device__ __forceinline__ float hi2f(unsigned u) { return __uint_as_float(u & 0xffff0000u); }
template <int MODE>
__device__ __forceinline__ void scan(GLAS unsigned char* lds, const GlaT& T, const int rowbase, const int nch, const int h, const int dir, const float* s0, float* sout, unsigned* myflag, unsigned* peerflag) {
    int tid_ = threadIdx.x; asm volatile("" : "+v"(tid_)); const int tid = tid_, lane = tid & 63, w = __builtin_amdgcn_readfirstlane(tid >> 6), g = lane >> 4, c = lane & 15;
    f32x4 S[8];
#pragma unroll
    for (int t = 0; t < 8; ++t) {
        if (s0) {
#pragma unroll
            for (int r = 0; r < 4; ++r) S[t][r] = s0[(size_t)(16 * t + 4 * g + r) * 128 + 16 * w + c];
        } else S[t] = (f32x4){0.f, 0.f, 0.f, 0.f};
    }
    const f32x4 ng = *(const f32x4*)(T.ngain + 16 * w + 4 * g);
    const size_t colq = (size_t)h * 128 + 2 * lane;
    const _Float16* Zd = T.Z + (size_t)dir * MTOK * 1024;
    const int dk0 = 2 * lane, pos0 = (dk0 & ~31) + 8 * ((dk0 >> 2) & 3) + 4 * ((dk0 >> 4) & 1) + (dk0 & 3);
    float oml0, oml1;
    { const float* rl = T.rlb + dir * 1024 + h * 128 + dk0; oml0 = 1.f - 1.f / (1.f + __builtin_amdgcn_exp2f((rl[0] - rl[2048]) * 1.4426950408889634f)); oml1 = 1.f - 1.f / (1.f + __builtin_amdgcn_exp2f((rl[1] - rl[2049]) * 1.4426950408889634f)); }
    const unsigned ldsb = (unsigned)(uintptr_t)lds;
#define GLA_DMA(ci) do { const int r0n_ = rowbase + 64 * (dir ? (nch - 1 - (ci)) : (ci)); _Pragma("unroll") for (int pc = 0; pc < 2; ++pc) { const int p_ = 8 * w + 4 * pc + (lane >> 4); \
        const size_t ro_ = (size_t)(r0n_ + (dir ? 63 - p_ : p_)) * 1024 + (size_t)h * 128 + 8 * (lane & 15); const unsigned ld_ = ldsb + RAW_OFF + (8 * w + 4 * pc) * 256; \
        glds16(Zd + ro_, (unsigned)__builtin_amdgcn_readfirstlane(ld_)); glds16(T.QR + ro_, (unsigned)__builtin_amdgcn_readfirstlane(ld_ + 16384)); glds16(T.VR + ro_, (unsigned)__builtin_amdgcn_readfirstlane(ld_ + 32768)); } } while (0)
    GLA_DMA(0);
    for (int i = 0; i < nch; ++i) {
        const int r0 = rowbase + 64 * (dir ? (nch - 1 - i) : i);
        if (MODE == 2 && 2 * i == nch) {
            if (tid == 0) { unsigned sp = 0; while (__hip_atomic_load(peerflag, __ATOMIC_RELAXED, __HIP_MEMORY_SCOPE_AGENT) == 0u) { __builtin_amdgcn_s_sleep(2); if (++sp > (1u << 22)) break; } } }
        asm volatile("s_waitcnt vmcnt(0)" ::: "memory");
        float cs0[8], cs1[8], kk0[8], kk1[8]; unsigned qv[8], vv[8]; float run0 = 0.f, run1 = 0.f;
#pragma unroll
        for (int ii = 0; ii < 8; ++ii) { const int p = 8 * w + ii;
            const f16x2 zz = *(const GLAS f16x2*)(lds + RAW_OFF + p * 256 + 4 * lane); qv[ii] = *(const GLAS unsigned*)(lds + RAW_OFF + 16384 + p * 256 + 4 * lane); vv[ii] = *(const GLAS unsigned*)(lds + RAW_OFF + 32768 + p * 256 + 4 * lane);
            const float k0 = oml0 * __builtin_amdgcn_rcpf(1.f + __builtin_amdgcn_exp2f((float)zz.x * 1.4426950408889634f)), k1 = oml1 * __builtin_amdgcn_rcpf(1.f + __builtin_amdgcn_exp2f((float)zz.y * 1.4426950408889634f));
            kk0[ii] = k0; kk1[ii] = k1; run0 += __builtin_amdgcn_logf(1.f - k0); run1 += __builtin_amdgcn_logf(1.f - k1); cs0[ii] = run0; cs1[ii] = run1; }
        *(GLAS f32x2*)(lds + TOT_OFF + (w * 128 + dk0) * 4) = (f32x2){run0, run1};
        __syncthreads();
        float pre0 = 0.f, pre1 = 0.f, br0 = 0.f, br1 = 0.f, bl0 = 0.f, bl1 = 0.f;
#pragma unroll
        for (int s = 0; s < 8; ++s) { const f32x2 t = *(const GLAS f32x2*)(lds + TOT_OFF + (s * 128 + dk0) * 4);
            if (s < w) { pre0 += t.x; pre1 += t.y; } if (s < 4) { br0 += t.x; br1 += t.y; } bl0 += t.x; bl1 += t.y; }
        const float c30 = __builtin_amdgcn_exp2f(bl0 - br0), c31 = __builtin_amdgcn_exp2f(bl1 - br1);
        if (w == 0) { *(GLAS f32x2*)(lds + EBR_OFF + dk0 * 4) = (f32x2){__builtin_amdgcn_exp2f(br0), __builtin_amdgcn_exp2f(br1)}; *(GLAS f32x2*)(lds + EBL_OFF + dk0 * 4) = (f32x2){__builtin_amdgcn_exp2f(bl0), __builtin_amdgcn_exp2f(bl1)}; }
        unsigned kh0[4], kh1[4], vt0[4], vt1[4];
#pragma unroll
        for (int ii = 0; ii < 8; ii += 2) {
            float ka[2], kb[2];
#pragma unroll
            for (int jj = 0; jj < 2; ++jj) { const int p = 8 * w + ii + jj;
                const float x0 = cs0[ii + jj] + pre0 - br0, x1 = cs1[ii + jj] + pre1 - br1;
                const float e10 = __builtin_amdgcn_exp2f(x0), e11 = __builtin_amdgcn_exp2f(x1), e20 = __builtin_amdgcn_exp2f(-x0), e21 = __builtin_amdgcn_exp2f(-x1);
                const float k0 = kk0[ii + jj] * e20, k1 = kk1[ii + jj] * e21;
                *(GLAS unsigned*)(lds + QT_OFF + p * QT_STR + pos0 * 2) = pkbf(lo2f(qv[ii + jj]) * e10, hi2f(qv[ii + jj]) * e11);
                *(GLAS unsigned*)(lds + KT_OFF + p * QT_STR + pos0 * 2) = pkbf(k0, k1);
                ka[jj] = k0 * c30; kb[jj] = k1 * c31; }
            kh0[ii >> 1] = pkbf(ka[0], ka[1]); kh1[ii >> 1] = pkbf(kb[0], kb[1]);
            vt0[ii >> 1] = (vv[ii] & 0xffffu) | (vv[ii + 1] << 16); vt1[ii >> 1] = (vv[ii] >> 16) | (vv[ii + 1] & 0xffff0000u);
        }
        *(GLAS u32x4*)(lds + KH_OFF + dk0 * KH_STR + 16 * w) = (u32x4){kh0[0], kh0[1], kh0[2], kh0[3]};
        *(GLAS u32x4*)(lds + KH_OFF + (dk0 + 1) * KH_STR + 16 * w) = (u32x4){kh1[0], kh1[1], kh1[2], kh1[3]};
        *(GLAS u32x4*)(lds + VT_OFF + dk0 * KH_STR + 16 * w) = (u32x4){vt0[0], vt0[1], vt0[2], vt0[3]};
        *(GLAS u32x4*)(lds + VT_OFF + (dk0 + 1) * KH_STR + 16 * w) = (u32x4){vt1[0], vt1[1], vt1[2], vt1[3]};
        asm volatile("s_waitcnt lgkmcnt(0)" ::: "memory");
        if (i + 1 < nch) GLA_DMA(i + 1);
        __syncthreads();
        { const int ti = w >> 1, si0 = 2 * (w & 1);
          bf16x8 sa[4], sb[4];
          if (si0 <= ti) {
#pragma unroll
            for (int ks = 0; ks < 4; ++ks) { sb[ks] = *(const GLAS bf16x8*)(lds + QT_OFF + (16 * ti + c) * QT_STR + 64 * ks + 16 * g); sa[ks] = *(const GLAS bf16x8*)(lds + KT_OFF + (16 * si0 + c) * QT_STR + 64 * ks + 16 * g); } }
#pragma unroll
          for (int q2 = 0; q2 < 2; ++q2) { const int si = si0 + q2; f32x4 a4 = (f32x4){0.f, 0.f, 0.f, 0.f};
            if (si <= ti) {
                if (q2 == 1) {
#pragma unroll
                    for (int ks = 0; ks < 4; ++ks) sa[ks] = *(const GLAS bf16x8*)(lds + KT_OFF + (16 * si + c) * QT_STR + 64 * ks + 16 * g); }
#pragma unroll
                for (int ks = 0; ks < 4; ++ks) a4 = __builtin_amdgcn_mfma_f32_16x16x32_bf16(sa[ks], sb[ks], a4, 0, 0, 0);
                if (si == ti) {
#pragma unroll
                    for (int r = 0; r < 4; ++r) if (4 * g + r > c) a4[r] = 0.f; }
            }
            *(GLAS u32x2*)(lds + AS_OFF + (16 * ti + c) * AS_STR + (16 * si + 4 * g) * 2) = (u32x2){pkbf(a4[0], a4[1]), pkbf(a4[2], a4[3])}; } }
        __syncthreads();
        const size_t cold = (size_t)h * 128 + 16 * w + 4 * g;
        const bool first_half = (MODE == 0) || (MODE == 2 && 2 * i < nch);
        u32x2 pf[4], gtv[4];
        if (!first_half) {
#pragma unroll
            for (int mt = 0; mt < 4; ++mt) { const int p = 16 * mt + c; const size_t ro = (size_t)(r0 + (dir ? 63 - p : p)) * 1024 + cold;
                if (MODE == 2) { const unsigned long long pv = __hip_atomic_load((const unsigned long long*)(T.OF + ro), __ATOMIC_RELAXED, __HIP_MEMORY_SCOPE_AGENT); pf[mt].x = (unsigned)pv; pf[mt].y = (unsigned)(pv >> 32); }
                else pf[mt] = *(const u32x2*)(T.OF + ro);
                gtv[mt] = *(const u32x2*)(T.GR + ro); }
        }
#define GSB() __builtin_amdgcn_sched_barrier(0)
#define LOADQ(qq, ee, ks) do { ee[0] = *(const GLAS f32x4*)(lds + EBR_OFF + (32 * (ks) + 4 * g) * 4); ee[1] = *(const GLAS f32x4*)(lds + EBR_OFF + (32 * (ks) + 16 + 4 * g) * 4); \
            _Pragma("unroll") for (int mt = 0; mt < 4; ++mt) qq[mt] = *(const GLAS bf16x8*)(lds + QT_OFF + (16 * mt + c) * QT_STR + 64 * (ks) + 16 * g); } while (0)
#define COMPQ(qq, ee, ks) do { const f32x4 s0v = S[2 * (ks)] * ee[0], s1v = S[2 * (ks) + 1] * ee[1]; \
            const u32x4 sw = (u32x4){pkbf(s0v[0], s0v[1]), pkbf(s0v[2], s0v[3]), pkbf(s1v[0], s1v[1]), pkbf(s1v[2], s1v[3])}; const bf16x8 sf = __builtin_bit_cast(bf16x8, sw); \
            _Pragma("unroll") for (int mt = 0; mt < 4; ++mt) o[mt] = __builtin_amdgcn_mfma_f32_16x16x32_bf16(sf, qq[mt], o[mt], 0, 0, 0); } while (0)
#define LOADK(kk, ll, t0) do { _Pragma("unroll") for (int t_ = 0; t_ < 2; ++t_) { ll[t_] = *(const GLAS f32x4*)(lds + EBL_OFF + (16 * ((t0) + t_) + 4 * g) * 4); \
            _Pragma("unroll") for (int sp = 0; sp < 2; ++sp) kk[t_][sp] = *(const GLAS bf16x8*)(lds + KH_OFF + (16 * ((t0) + t_) + c) * KH_STR + 64 * sp + 16 * g); } } while (0)
#define COMPK(kk, ll, t0) do { _Pragma("unroll") for (int t_ = 0; t_ < 2; ++t_) { S[(t0) + t_] = S[(t0) + t_] * ll[t_]; \
            _Pragma("unroll") for (int sp = 0; sp < 2; ++sp) S[(t0) + t_] = __builtin_amdgcn_mfma_f32_16x16x32_bf16(kk[t_][sp], vf[sp], S[(t0) + t_], 0, 0, 0); } } while (0)
        bf16x8 vf[2];
#pragma unroll
        for (int sp = 0; sp < 2; ++sp) vf[sp] = *(const GLAS bf16x8*)(lds + VT_OFF + (16 * w + c) * KH_STR + 64 * sp + 16 * g);
        f32x4 o[4];
#pragma unroll
        for (int mt = 0; mt < 4; ++mt) o[mt] = (f32x4){0.f, 0.f, 0.f, 0.f};
        { bf16x8 qA[4], qB[4]; f32x4 eA[2], eB[2];
          LOADQ(qA, eA, 0); LOADQ(qB, eB, 1); GSB();
          COMPQ(qA, eA, 0); GSB(); LOADQ(qA, eA, 2); GSB();
          COMPQ(qB, eB, 1); GSB(); LOADQ(qB, eB, 3); GSB();
          COMPQ(qA, eA, 2); GSB();
          bf16x8 af[6];
          af[0] = *(const GLAS bf16x8*)(lds + AS_OFF + (0 + c) * AS_STR + 16 * g); af[1] = *(const GLAS bf16x8*)(lds + AS_OFF + (16 + c) * AS_STR + 16 * g);
          af[2] = *(const GLAS bf16x8*)(lds + AS_OFF + (32 + c) * AS_STR + 16 * g); af[3] = *(const GLAS bf16x8*)(lds + AS_OFF + (32 + c) * AS_STR + 64 + 16 * g);
          af[4] = *(const GLAS bf16x8*)(lds + AS_OFF + (48 + c) * AS_STR + 16 * g); af[5] = *(const GLAS bf16x8*)(lds + AS_OFF + (48 + c) * AS_STR + 64 + 16 * g); GSB();
          COMPQ(qB, eB, 3); GSB();
          bf16x8 kA[2][2], kB[2][2]; f32x4 lA[2], lB[2];
          LOADK(kA, lA, 0); GSB();
          o[0] = __builtin_amdgcn_mfma_f32_16x16x32_bf16(vf[0], af[0], o[0], 0, 0, 0); o[1] = __builtin_amdgcn_mfma_f32_16x16x32_bf16(vf[0], af[1], o[1], 0, 0, 0);
          o[2] = __builtin_amdgcn_mfma_f32_16x16x32_bf16(vf[0], af[2], o[2], 0, 0, 0); o[2] = __builtin_amdgcn_mfma_f32_16x16x32_bf16(vf[1], af[3], o[2], 0, 0, 0);
          o[3] = __builtin_amdgcn_mfma_f32_16x16x32_bf16(vf[0], af[4], o[3], 0, 0, 0); o[3] = __builtin_amdgcn_mfma_f32_16x16x32_bf16(vf[1], af[5], o[3], 0, 0, 0); GSB();
          LOADK(kB, lB, 2); GSB(); COMPK(kA, lA, 0); GSB();
          LOADK(kA, lA, 4); GSB(); COMPK(kB, lB, 2); GSB();
          LOADK(kB, lB, 6); GSB(); COMPK(kA, lA, 4); GSB();
          COMPK(kB, lB, 6); GSB(); }
#undef LOADQ
#undef COMPQ
#undef LOADK
#undef COMPK
#undef GSB
        if (first_half) {
#pragma unroll
            for (int mt = 0; mt < 4; ++mt) { const int p = 16 * mt + c; const size_t ro = (size_t)(r0 + (dir ? 63 - p : p)) * 1024 + cold;
                const unsigned long long pv = (unsigned long long)pkbf(o[mt][0], o[mt][1]) | ((unsigned long long)pkbf(o[mt][2], o[mt][3]) << 32);
                if (MODE == 2) __hip_atomic_store((unsigned long long*)(T.OF + ro), pv, __ATOMIC_RELAXED, __HIP_MEMORY_SCOPE_AGENT);
                else *(unsigned long long*)(T.OF + ro) = pv; }
            if (MODE == 2 && 2 * (i + 1) == nch) {
                asm volatile("s_waitcnt vmcnt(0)" ::: "memory"); __syncthreads();
                if (tid == 0) __hip_atomic_store(myflag, 1u, __ATOMIC_RELAXED, __HIP_MEMORY_SCOPE_AGENT); }
        } else {

            float ss[4];
#pragma unroll
            for (int mt = 0; mt < 4; ++mt) { const int p = 16 * mt + c; const size_t ro = (size_t)(r0 + (dir ? 63 - p : p)) * 1024 + cold;
                o[mt][0] += lo2f(pf[mt].x); o[mt][1] += hi2f(pf[mt].x); o[mt][2] += lo2f(pf[mt].y); o[mt][3] += hi2f(pf[mt].y);
                float s = (o[mt][0] * o[mt][0] + o[mt][1] * o[mt][1]) + (o[mt][2] * o[mt][2] + o[mt][3] * o[mt][3]);
                s += __shfl_xor(s, 16); s += __shfl_xor(s, 32); ss[mt] = s;
                if (g == 0) *(GLAS float*)(lds + RS_OFF + (w * 64 + p) * 4) = s; }
            __syncthreads();
#pragma unroll
            for (int mt = 0; mt < 4; ++mt) { const int p = 16 * mt + c; float tot = 0.f;
#pragma unroll
                for (int ww = 0; ww < 8; ++ww) tot += *(const GLAS float*)(lds + RS_OFF + (ww * 64 + p) * 4);
                const float rinv = rsqrtf(tot * (1.0f / 128.0f) + 1e-6f);
                const size_t ro = (size_t)(r0 + (dir ? 63 - p : p)) * 1024 + cold;
                const u32x2 gt = gtv[mt];
                const float y0 = o[mt][0] * rinv * ng[0] * lo2f(gt.x), y1 = o[mt][1] * rinv * ng[1] * hi2f(gt.x), y2 = o[mt][2] * rinv * ng[2] * lo2f(gt.y), y3 = o[mt][3] * rinv * ng[3] * hi2f(gt.y);
                *(u32x2*)(T.GO + ro) = (u32x2){pkbf(y0, y1), pkbf(y2, y3)}; }
        }
    }
    if (sout) {
#pragma unroll
        for (int t = 0; t < 8; ++t)
#pragma unroll
            for (int r = 0; r < 4; ++r) sout[(size_t)(16 * t + 4 * g + r) * 128 + 16 * w + c] = S[t][r];
    }
}
#undef GLA_DMA
#undef GLAS
}
struct Args { const float* in[19]; float* out; unsigned char* ws; int ph_lo, ph_hi, li, pad; };
__global__ void __launch_bounds__(NWAVES * 64, 2) mk_fwd(Args args) {
    extern __shared__ __attribute__((aligned(16))) unsigned char lds[];
    Frame F;
    F.lds = (LAS unsigned char*)lds;
    F.MISC = (volatile LAS unsigned*)(F.lds + MISC_OFF);
    F.tid = threadIdx.x; F.lane = F.tid & 63; F.wave = __builtin_amdgcn_readfirstlane(F.tid >> 6);
    F.G = gridDim.x; { const int bx = blockIdx.x; F.vcu = (F.G % 8 == 0) ? (bx % 8) * (F.G / 8) + bx / 8 : bx; }
    Ptrs P;
    P.x_prompt = args.in[0]; P.x_sample = args.in[1]; P.cache_k = args.in[2]; P.cache_v = args.in[3]; P.state_rec = args.in[4]; P.c = args.in[5]; P.c_ctx = args.in[6];
    P.ada_w = args.in[7]; P.ada_b = args.in[8]; P.attn_w_in = args.in[9]; P.attn_q_gain = args.in[10]; P.attn_k_gain = args.in[11]; P.attn_w_out = args.in[12];
    P.rec_w_in = args.in[13]; P.rec_lb = args.in[14]; P.rec_norm_gain = args.in[15]; P.rec_w_out = args.in[16]; P.ln_gain = args.in[17]; P.ln_bias = args.in[18];
    P.out = args.out; P.ws = args.ws;
    unsigned char* ws = args.ws;
    F.ctl = (gu32*)(ws + WS_CTL);
    for (int u = F.tid; u < (LDS_BYTES - LDSCTL_OFF) / 4; u += NWAVES * 64) ((LAS unsigned*)(F.lds + LDSCTL_OFF))[u] = 0u;
    __syncthreads();
    XcdBarrier bar; bar.bar = (unsigned*)(F.ctl + CW_BAR); bar.x = 0; bar.st = nullptr;
    if (N_LAUNCHES == 1) bar = xcd_barrier_post((unsigned*)(F.ctl + CW_BAR), F.MISC + 8);
#define GRID_BAR() do { if (N_LAUNCHES == 1) xcd_barrier(bar); } while (0)
    const int lo = args.ph_lo, hi = args.ph_hi;
#define IN(k) (lo <= (k) && (k) < hi)
#define BOTH(k) (IN(k) && IN((k) + 1))
#ifndef MK_REPEAT
#define MK_REPEAT (-1)
#endif
#define REP(k) _Pragma("unroll") for (int rep_ = 0; rep_ < ((MK_REPEAT == (k)) ? 2 : 1); ++rep_)
    bf16* const W1 = (bf16*)(ws + WS_W1); bf16* const W2 = (bf16*)(ws + WS_W2); bf16* const W3 = (bf16*)(ws + WS_W3); bf16* const W4 = (bf16*)(ws + WS_W4);
    bf16* const HA = (bf16*)(ws + WS_A); bf16* const QB_ = (bf16*)(ws + WS_B); bf16* const GC = (bf16*)(ws + WS_C); bf16* const AOD = (bf16*)(ws + WS_D);
    bf16* const Kall = (bf16*)(ws + WS_KALL); bf16* const Vall = (bf16*)(ws + WS_VALL);
    const float* const mod = (const float*)(ws + WS_MOD);
    float* const Y = P.out + OUT_Y;

    REP(0) if (IN(0)) { p0_prologue(F, P, rep_ == 0); if (BOTH(0)) GRID_BAR(); }
    REP(1) if (IN(1)) { p1_modulate(F, P); if (BOTH(1)) GRID_BAR(); }
    REP(2) if (IN(2)) {
        pg8::Gemm g{HA, W1, MTOK, N1, DM}; pg8::StaticOrder S; S.init(MTOK, N1, F.G, (int)blockIdx.x);
        pg8::EpiAttnIn E{QB_, Kall, Vall, GC, P.out + OUT_K, P.out + OUT_V, P.attn_q_gain, P.attn_k_gain, (const float*)(ws + WS_ROPE)};
        pg8::gemm_phase<pg8::EpiAttnIn, pg8::StaticOrder, true, true>(F.lds + RING_OFF, g, S, E);
        if (BOTH(2)) GRID_BAR();
    }
    REP(3) if (IN(3)) {
        typedef attn_body::bf16 abf;
        for (int v = F.vcu; v < 256; v += F.G) {
            { const int b = v >> 6, h = (v >> 2) & 15, qb = v & 3; const size_t qo = (size_t)(MP + b * L_S + qb * 256) * DM + h * 64; const size_t ko = (size_t)(MP + b * 1280) * 256 + (h >> 2) * 64;
              attn_body::attn_unit<8>((const abf*)QB_ + qo, (const abf*)Kall + ko, (const abf*)Vall + ko, 20, (abf*)AOD + qo, (const abf*)GC + qo, (char*)lds + RING_OFF); }
#pragma unroll 1
            for (int j = 0; j < 2; ++j) { const int u = 2 * v + j, b = u >> 4, h = u & 15; const size_t qo = (size_t)(b * L_P) * DM + h * 64; const size_t ko = (size_t)(b * L_P) * 256 + (h >> 2) * 64;
              attn_body::attn_unit<8>((const abf*)QB_ + qo, (const abf*)Kall + ko, (const abf*)Vall + ko, 4, (abf*)AOD + qo, (const abf*)GC + qo, (char*)lds + RING_OFF); }
        }
        if (BOTH(3)) GRID_BAR();
    }
    REP(4) if (IN(4)) {
        pg8::Gemm g{AOD, W2, MTOK, DM, DM}; pg8::StaticOrder S; S.init(MTOK, DM, F.G, (int)blockIdx.x);
        pg8::EpiRes E{P.x_prompt, P.x_sample, Y, mod + 2048};
        pg8::gemm_phase<pg8::EpiRes, pg8::StaticOrder, true, true>(F.lds + RING_OFF, g, S, E);
        if (BOTH(4)) GRID_BAR();
    }
    if (IN(5)) { p_layernorm<true>(F, P, Y, P.ln_gain, P.ln_bias, mod + 5 * 3072); if (BOTH(5)) GRID_BAR(); }
    REP(6) if (IN(6)) {
        pg8::Gemm g{HA, W3, MTOK, N3, DM}; pg8::StaticOrder S; S.init(MTOK, N3, F.G, (int)blockIdx.x);
        pg8::EpiRecIn E{QB_, GC, AOD, (_Float16*)(ws + WS_LF)};
        pg8::gemm_phase<pg8::EpiRecIn, pg8::StaticOrder, true, true>(F.lds + RING_OFF, g, S, E);
        if (BOTH(6)) GRID_BAR();
    }
    REP(7) if (IN(7)) {
        gla::GlaT T{QB_, GC, AOD, (const _Float16*)(ws + WS_LF), (bf16*)(ws + WS_OF), HA, P.rec_norm_gain, P.rec_lb};
        const int bx = blockIdx.x;
        if (F.G >= 128) {
            if (bx < 64) { const int u = bx, b = u >> 4, h = (u >> 1) & 7, dir = u & 1; const float* s0 = P.state_rec + ((size_t)(b * 2 + dir) * 8 + h) * 16384;
                gla::scan<2>(F.lds + RING_OFF, T, MP + b * L_S, L_S / 64, h, dir, s0, nullptr, (unsigned*)(F.ctl + CW_GLA + 64 * u), (unsigned*)(F.ctl + CW_GLA + 64 * (u ^ 1))); }
            else for (int u = bx - 64; u < 256; u += F.G - 64) { const int b = u >> 3, h = u & 7; float* so = P.out + OUT_S + ((size_t)(b * 2 + 0) * 8 + h) * 16384;
                gla::scan<0>(F.lds + RING_OFF, T, b * L_P, L_P / 64, h, 0, nullptr, so, nullptr, nullptr);
                gla::scan<1>(F.lds + RING_OFF, T, b * L_P, L_P / 64, h, 1, nullptr, so + 8 * 16384, nullptr, nullptr); }
        } else {
            for (int u = bx; u < 32 + 256; u += F.G) {
                if (u < 32) { const int b = u >> 3, h = u & 7; const float* s0 = P.state_rec + ((size_t)(b * 2 + 0) * 8 + h) * 16384;
                    gla::scan<0>(F.lds + RING_OFF, T, MP + b * L_S, L_S / 64, h, 0, s0, nullptr, nullptr, nullptr);
                    gla::scan<1>(F.lds + RING_OFF, T, MP + b * L_S, L_S / 64, h, 1, s0 + 8 * 16384, nullptr, nullptr, nullptr); }
                else { const int v = u - 32, b = v >> 3, h = v & 7; float* so = P.out + OUT_S + ((size_t)(b * 2 + 0) * 8 + h) * 16384;
                    gla::scan<0>(F.lds + RING_OFF, T, b * L_P, L_P / 64, h, 0, nullptr, so, nullptr, nullptr);
                    gla::scan<1>(F.lds + RING_OFF, T, b * L_P, L_P / 64, h, 1, nullptr, so + 8 * 16384, nullptr, nullptr); } }
        }
        if (BOTH(7)) GRID_BAR();
    }
    if (IN(8)) {
        pg8::Gemm g{HA, W4, MTOK, DM, DM}; pg8::StaticOrder S; S.init(MTOK, DM, F.G, (int)blockIdx.x);
        pg8::EpiRes E{Y, Y + (size_t)MP * DM, Y, mod + 5 * 3072 + 2048};
        pg8::gemm_phase<pg8::EpiRes, pg8::StaticOrder, true, true>(F.lds + RING_OFF, g, S, E);
        if (BOTH(8)) GRID_BAR();
    }
    if (IN(9)) { p_layernorm<false>(F, P, Y, P.ln_gain + DM, P.ln_bias + DM, mod); }
#undef IN
#undef BOTH
#undef GRID_BAR
}

extern "C" void kernel_launch(void* const* d_in, const int* in_sizes, int n_in, void* d_out, int out_size, void* d_ws, size_t ws_size, hipStream_t stream) {
    static int grid = 0;
    if (grid == 0) {
        if (n_in != 19 || in_sizes[0] != MP * DM || in_sizes[1] != NB_S * L_S * DM || (size_t)out_size != OUT_END || ws_size < WS_END) {
            fprintf(stderr, "kernel_launch: unexpected shapes: n_in %d in0 %d in1 %d out %d ws %zu; nothing launched\n", n_in, n_in > 0 ? in_sizes[0] : -1, n_in > 1 ? in_sizes[1] : -1, out_size, ws_size); grid = -1; return; }
        int dev = 0, cus = 0, per_cu = 0;
        if (hipGetDevice(&dev) != hipSuccess || hipDeviceGetAttribute(&cus, hipDeviceAttributeMultiprocessorCount, dev) != hipSuccess) { fprintf(stderr, "kernel_launch: device query failed\n"); grid = -1; return; }
        if (hipFuncSetAttribute((const void*)mk_fwd, hipFuncAttributeMaxDynamicSharedMemorySize, LDS_BYTES) != hipSuccess) { fprintf(stderr, "kernel_launch: hipFuncSetAttribute failed\n"); grid = -1; return; }
        if (hipOccupancyMaxActiveBlocksPerMultiprocessor(&per_cu, (const void*)mk_fwd, NWAVES * 64, LDS_BYTES) != hipSuccess || per_cu < 1)
            fprintf(stderr, "kernel_launch: note: occupancy query reports %d workgroups per CU\n", per_cu);
        (void)hipGetLastError();
        grid = cus;
    }
    if (grid < 0) return;
    if (hipMemsetAsync((char*)d_ws + WS_CTL, 0, CTL_ZERO_BYTES, stream) != hipSuccess) { fprintf(stderr, "kernel_launch: memset failed\n"); return; }
    Args a{};
    for (int i = 0; i < 19; ++i) a.in[i] = (const float*)d_in[i];
    a.out = (float*)d_out; a.ws = (unsigned char*)d_ws;
    for (int li = 0; li < N_LAUNCHES; ++li) {
        a.ph_lo = (N_LAUNCHES == 1) ? 0 : li; a.ph_hi = (N_LAUNCHES == 1) ? NPHASE : li + 1; a.li = li;
        hipLaunchKernelGGL(mk_fwd, dim3(grid), dim3(NWAVES * 64), LDS_BYTES, stream, a);
        const hipError_t le = hipPeekAtLastError();
        if (le != hipSuccess) { fprintf(stderr, "kernel_launch: launch %d failed: %s\n", li, hipGetErrorName(le)); break; }
    }
}
```
